# Optimizing an MI355X kernel written in HIP

```python
import math
import jax, jax.numpy as jnp
from jax import lax
import numpy as np

D_MODEL = 1024
BATCH = 2
SEQ = 8192
DEPTH = 1

CHUNK = 64
Q_BLOCK = 128
MEM_LEN = 256
EPS = 1e-6
NEG_INF = -1e30
MLA_HEADS = 8
MLA_Q_LORA = 384
MLA_KV_LORA = 256
MLA_NOPE = 64
MLA_ROPE = 32
MLA_V = 64
ROPE_BASE = 10000.0
DIFF_HEADS = 8
DIFF_DIM = 64
DIFF_WIDTH = DIFF_HEADS * 2 * DIFF_DIM
N_BUCKETS = 32
MAX_DISTANCE = 128
XATTN_HEADS = 4
XATTN_DIM = 128
D_FF = 2816
IN_SPLITS = (MLA_Q_LORA, MLA_KV_LORA, MLA_ROPE, DIFF_WIDTH, DIFF_WIDTH, DIFF_WIDTH, D_MODEL, D_MODEL)
N_IN = sum(IN_SPLITS)

kernel_name = 'hybrid_mla_diffattn_macaron_layer'


def rmsnorm(x, g):
    xf = x.astype(jnp.float32)
    y = xf * lax.rsqrt(jnp.mean(xf * xf, axis=-1, keepdims=True) + EPS)
    return (y * g.astype(jnp.float32)).astype(x.dtype)


def swiglu(x, w_gate, w_up, w_down):
    return (jax.nn.silu(x @ w_gate) * (x @ w_up)) @ w_down


def rope(x, pos):
    half = x.shape[-1] // 2
    freqs = ROPE_BASE ** (-jnp.arange(half, dtype=jnp.float32) / half)
    ang = pos.astype(jnp.float32)[:, None] * freqs[None, :]
    cos = jnp.cos(ang)[:, None, :].astype(x.dtype)
    sin = jnp.sin(ang)[:, None, :].astype(x.dtype)
    x1, x2 = x[..., :half], x[..., half:]
    return jnp.concatenate([x1 * cos - x2 * sin, x1 * sin + x2 * cos], axis=-1)


def t5_bucket(rel):
    half = N_BUCKETS // 2
    max_exact = half // 2
    ret = jnp.where(rel > 0, half, 0)
    n = jnp.abs(rel)
    nf = jnp.maximum(n, 1).astype(jnp.float32)
    large = max_exact + (jnp.log(nf / max_exact) / math.log(MAX_DISTANCE / max_exact) * (half - max_exact)).astype(jnp.int32)
    large = jnp.minimum(large, half - 1)
    return ret + jnp.where(n < max_exact, n, large)


def chunk_mask(q_pos, k_pos):
    return (k_pos // CHUNK)[None, :] <= (q_pos // CHUNK)[:, None]


def to_blocks(t):
    b, s = t.shape[:2]
    return jnp.moveaxis(t.reshape(b, s // Q_BLOCK, Q_BLOCK, *t.shape[2:]), 1, 0)


def from_blocks(t):
    t = jnp.moveaxis(t, 0, 1)
    return t.reshape(t.shape[0], t.shape[1] * t.shape[2], *t.shape[3:])


def mla_attention(q, k, v):
    s_len = q.shape[1]
    k_pos = jnp.arange(s_len)
    q_pos_blocks = k_pos.reshape(-1, Q_BLOCK)
    scale = (MLA_NOPE + MLA_ROPE) ** -0.5

    def one(args):
        qb, qp = args
        logits = jnp.einsum('bqhd,bkhd->bhqk', qb, k).astype(jnp.float32) * scale
        logits = jnp.where(chunk_mask(qp, k_pos), logits, NEG_INF)
        p = jax.nn.softmax(logits, axis=-1).astype(v.dtype)
        return jnp.einsum('bhqk,bkhd->bqhd', p, v)

    return from_blocks(lax.map(one, (to_blocks(q), q_pos_blocks)))


def diff_attention(q1, q2, k1, k2, v, lam, rel_bias):
    s_len = q1.shape[1]
    k_pos = jnp.arange(s_len)
    q_pos_blocks = k_pos.reshape(-1, Q_BLOCK)
    scale = DIFF_DIM ** -0.5
    table = rel_bias.astype(jnp.float32)

    def one(args):
        q1b, q2b, qp = args
        mask = chunk_mask(qp, k_pos)
        bias = jnp.transpose(table[t5_bucket(k_pos[None, :] - qp[:, None])], (2, 0, 1))[None]

        def probs(qb, kk):
            logits = jnp.einsum('bqhd,bkhd->bhqk', qb, kk).astype(jnp.float32) * scale + bias
            return jax.nn.softmax(jnp.where(mask, logits, NEG_INF), axis=-1)

        attn = probs(q1b, k1) - lam * probs(q2b, k2)
        return jnp.einsum('bhqk,bkhd->bqhd', attn.astype(v.dtype), v)

    return from_blocks(lax.map(one, (to_blocks(q1), to_blocks(q2), q_pos_blocks)))


def mla_branch(q_lat, kv_lat, k_rope, pos, q_norm, w_q_up, kv_norm, w_kv_up):
    b, s = q_lat.shape[:2]
    q = (rmsnorm(q_lat, q_norm) @ w_q_up).reshape(b, s, MLA_HEADS, MLA_NOPE + MLA_ROPE)
    q = jnp.concatenate([q[..., :MLA_NOPE], rope(q[..., MLA_NOPE:], pos)], axis=-1)
    kv = (rmsnorm(kv_lat, kv_norm) @ w_kv_up).reshape(b, s, MLA_HEADS, MLA_NOPE + MLA_V)
    k_r = jnp.broadcast_to(rope(k_rope[:, :, None, :], pos), (b, s, MLA_HEADS, MLA_ROPE))
    k = jnp.concatenate([kv[..., :MLA_NOPE], k_r], axis=-1)
    v = kv[..., MLA_NOPE:]
    return mla_attention(q, k, v).reshape(b, s, MLA_HEADS * MLA_V)


def diff_branch(dq, dk, dv, layer, lam_q1, lam_k1, lam_q2, lam_k2, sub_norm, rel_bias):
    b, s = dq.shape[:2]
    q = dq.reshape(b, s, DIFF_HEADS, 2, DIFF_DIM)
    k = dk.reshape(b, s, DIFF_HEADS, 2, DIFF_DIM)
    v = dv.reshape(b, s, DIFF_HEADS, 2 * DIFF_DIM)
    lam_init = 0.8 - 0.6 * math.exp(-0.3 * layer)
    f32 = jnp.float32
    lam = (jnp.exp(jnp.sum(lam_q1.astype(f32) * lam_k1.astype(f32)))
           - jnp.exp(jnp.sum(lam_q2.astype(f32) * lam_k2.astype(f32))) + lam_init)
    o = diff_attention(q[..., 0, :], q[..., 1, :], k[..., 0, :], k[..., 1, :], v, lam, rel_bias)
    o = rmsnorm(o, sub_norm) * (1.0 - lam_init)
    return o.reshape(b, s, DIFF_WIDTH)


def memory_cross_attention(u, m, w_q, w_kv, w_o):
    b, s = u.shape[:2]
    q = (u @ w_q).reshape(b, s, XATTN_HEADS, XATTN_DIM)
    k, v = jnp.split((m @ w_kv).reshape(b, m.shape[1], XATTN_HEADS, 2 * XATTN_DIM), 2, axis=-1)
    logits = jnp.einsum('bqhd,bkhd->bhqk', q, k).astype(jnp.float32) * (XATTN_DIM ** -0.5)
    p = jax.nn.softmax(logits, axis=-1).astype(v.dtype)
    o = jnp.einsum('bhqk,bkhd->bqhd', p, v).reshape(b, s, XATTN_HEADS * XATTN_DIM)
    return o @ w_o


def setup_inputs(seed: int = 0) -> dict:
    key = jax.random.key(seed)
    ks = iter(jax.random.split(key, 40))

    def dense(shape, fan_in):
        return jax.random.normal(next(ks), shape, jnp.float32) * (fan_in ** -0.5)

    def gain(shape):
        return 1.0 + 0.02 * jax.random.normal(next(ks), shape, jnp.float32)

    def small(shape, scale):
        return scale * jax.random.normal(next(ks), shape, jnp.float32)

    L, D = DEPTH, D_MODEL
    return {
        'x': jax.random.normal(next(ks), (BATCH, SEQ, D), jnp.float32),
        'mem': jax.random.normal(next(ks), (BATCH, MEM_LEN, D), jnp.float32),
        'ffn1_norm': gain((L, D)),
        'ffn1_w_gate': dense((L, D, D_FF), D),
        'ffn1_w_up': dense((L, D, D_FF), D),
        'ffn1_w_down': dense((L, D_FF, D), D_FF),
        'mix_norm': gain((L, D)),
        'w_in': dense((L, D, N_IN), D),
        'mla_q_norm': gain((L, MLA_Q_LORA)),
        'mla_w_q_up': dense((L, MLA_Q_LORA, MLA_HEADS * (MLA_NOPE + MLA_ROPE)), MLA_Q_LORA),
        'mla_kv_norm': gain((L, MLA_KV_LORA)),
        'mla_w_kv_up': dense((L, MLA_KV_LORA, MLA_HEADS * (MLA_NOPE + MLA_V)), MLA_KV_LORA),
        'diff_lambda_q1': small((L, DIFF_DIM), 0.1),
        'diff_lambda_k1': small((L, DIFF_DIM), 0.1),
        'diff_lambda_q2': small((L, DIFF_DIM), 0.1),
        'diff_lambda_k2': small((L, DIFF_DIM), 0.1),
        'diff_sub_norm': gain((L, 2 * DIFF_DIM)),
        'rel_bias': small((N_BUCKETS, DIFF_HEADS), 0.5),
        'w_branch_a': dense((L, MLA_HEADS * MLA_V, D), MLA_HEADS * MLA_V),
        'w_branch_b': dense((L, DIFF_WIDTH, D), DIFF_WIDTH),
        'w_out': dense((L, D, D), D),
        'xattn_norm': gain((L, D)),
        'mem_norm': gain((L, D)),
        'xattn_w_q': dense((L, D, XATTN_HEADS * XATTN_DIM), D),
        'xattn_w_kv': dense((L, D, 2 * XATTN_HEADS * XATTN_DIM), D),
        'xattn_w_o': dense((L, XATTN_HEADS * XATTN_DIM, D), XATTN_HEADS * XATTN_DIM),
        'ffn2_norm': gain((L, D)),
        'ffn2_w_gate': dense((L, D, D_FF), D),
        'ffn2_w_up': dense((L, D, D_FF), D),
        'ffn2_w_down': dense((L, D_FF, D), D_FF),
        'final_norm': gain((D,)),
    }


def reference(x, mem, ffn1_norm, ffn1_w_gate, ffn1_w_up, ffn1_w_down, mix_norm, w_in,
              mla_q_norm, mla_w_q_up, mla_kv_norm, mla_w_kv_up,
              diff_lambda_q1, diff_lambda_k1, diff_lambda_q2, diff_lambda_k2, diff_sub_norm,
              rel_bias, w_branch_a, w_branch_b, w_out,
              xattn_norm, mem_norm, xattn_w_q, xattn_w_kv, xattn_w_o,
              ffn2_norm, ffn2_w_gate, ffn2_w_up, ffn2_w_down, final_norm):
    pos = jnp.arange(x.shape[1])
    offsets = np.cumsum(IN_SPLITS)[:-1].tolist()
    h = x
    for l in range(DEPTH):
        h = h + 0.5 * swiglu(rmsnorm(h, ffn1_norm[l]), ffn1_w_gate[l], ffn1_w_up[l], ffn1_w_down[l])
        u = rmsnorm(h, mix_norm[l])
        q_lat, kv_lat, k_rope, dq, dk, dv, gate_a, gate_b = jnp.split(u @ w_in[l], offsets, axis=-1)
        y_a = mla_branch(q_lat, kv_lat, k_rope, pos, mla_q_norm[l], mla_w_q_up[l],
                         mla_kv_norm[l], mla_w_kv_up[l]) @ w_branch_a[l]
        y_b = diff_branch(dq, dk, dv, l, diff_lambda_q1[l], diff_lambda_k1[l], diff_lambda_q2[l],
                          diff_lambda_k2[l], diff_sub_norm[l], rel_bias) @ w_branch_b[l]
        merged = jax.nn.sigmoid(gate_a) * y_a + jax.nn.sigmoid(gate_b) * y_b
        h = h + merged @ w_out[l]
        h = h + memory_cross_attention(rmsnorm(h, xattn_norm[l]), rmsnorm(mem, mem_norm[l]),
                                       xattn_w_q[l], xattn_w_kv[l], xattn_w_o[l])
        h = h + 0.5 * swiglu(rmsnorm(h, ffn2_norm[l]), ffn2_w_gate[l], ffn2_w_up[l], ffn2_w_down[l])
    return rmsnorm(h, final_norm)
```

```cpp
#include <hip/hip_runtime.h>
#include <cstdio>
#include <cstdint>
#include <cmath>
namespace pg8 {
#define PG8_LAS __attribute__((address_space(3)))
typedef unsigned short bf16_t;
typedef short bf16x8 __attribute__((ext_vector_type(8)));
typedef float f32x4 __attribute__((ext_vector_type(4)));
typedef unsigned u32x4 __attribute__((ext_vector_type(4)));
typedef unsigned u32x2 __attribute__((ext_vector_type(2)));
constexpr int BM = 256, BK = 64, HALF = 128, HTB = HALF * BK * 2  , STAGE_BYTES = 8 * HTB, NXCD = 8, WGM = 8;

__host__ __device__ __forceinline__ int lds_byte(int r, int c) { const int st = (r >> 4) * 2 + (c >> 5), rr = r & 15, cc = c & 31, ob = rr * 64 + cc * 2; return st * 1024 + (ob ^ (((ob >> 9) & 1) << 5)); }
__host__ __device__ __forceinline__ void stage_rc(int b, int& R, int& C) { const int st = b / 1024, sb = b % 1024, swz = sb ^ (((sb >> 9) & 1) << 5); R = (st >> 1) * 16 + swz / 64; C = (st & 1) * 32 + (swz % 64) / 2; }
__host__ __device__ __forceinline__ int perm32(int rho) { const int n = rho >> 4, i = rho & 15; return 8 * (i >> 2) + 4 * n + (i & 3); }

struct Unit { int pm, pn; };
struct Gemm { const bf16_t* A; const bf16_t* Bt; int M, N, K, lda; };

struct StaticOrder {
    int nM, nN, nwg, G, c;
    __host__ __device__ void init(int M, int N, int G_, int c_) { nM = M / BM; nN = N / BM; nwg = nM * nN; G = G_; c = c_; }
    __host__ __device__ bool next(int i, Unit& u) const {
        if (c < 0) return false;
        const long L = (long)i * G + c; if (L >= nwg) return false;
        int wgid = (int)L; { const int q = nwg / NXCD, r = nwg % NXCD, xcd = wgid % NXCD, off = wgid / NXCD; wgid = (xcd < r ? xcd * (q + 1) : r * (q + 1) + (xcd - r) * q) + off; }
        const int nig = WGM * nN, gid = wgid / nig, fm = gid * WGM, gsz = (nM - fm) < WGM ? (nM - fm) : WGM;
        u.pm = fm + ((wgid % nig) % gsz); u.pn = (wgid % nig) / gsz; return true;
    }
    __device__ __forceinline__ void a_ready(const Unit&) const {}
    __device__ __forceinline__ void done(const Unit&) const {}
};

typedef float f32x2 __attribute__((ext_vector_type(2))); typedef __bf16 bf16x2_t __attribute__((ext_vector_type(2)));
__device__ __forceinline__ unsigned cvt_pk_bf16(float lo, float hi) { f32x2 v = {lo, hi}; bf16x2_t b = __builtin_convertvector(v, bf16x2_t); return __builtin_bit_cast(unsigned, b); }
__device__ __forceinline__ u32x4 pack8(f32x4 a, f32x4 b) { u32x4 w; w.x = cvt_pk_bf16(a[0], a[1]); w.y = cvt_pk_bf16(a[2], a[3]); w.z = cvt_pk_bf16(b[0], b[1]); w.w = cvt_pk_bf16(b[2], b[3]); return w; }
__device__ __forceinline__ u32x2 pack4(f32x4 a) { u32x2 w; w.x = cvt_pk_bf16(a[0], a[1]); w.y = cvt_pk_bf16(a[2], a[3]); return w; }
__device__ __forceinline__ float bf_lo(unsigned w) { return __uint_as_float(w << 16); }
__device__ __forceinline__ float bf_hi(unsigned w) { return __uint_as_float(w & 0xffff0000u); }
constexpr float RMS_EPS = 1e-6f;
template <int NV4> __device__ __forceinline__ float parts_sum(const float* p, int fq) {
    const f32x4 v = *(const f32x4*)(p + 4 * (fq < NV4 ? fq : NV4 - 1)); float s = (v[0] + v[1]) + (v[2] + v[3]);
    if (NV4 < 4) s = fq < NV4 ? s : 0.f;
    s += __shfl_xor(s, 16); s += __shfl_xor(s, 32);
    return s;
}
template <int NV4> __device__ __forceinline__ void unit_rstd(float (&rs)[2][4], const float* parts, int pitch, int row0, int fq, float inv_dim) {
#pragma unroll
    for (int ai = 0; ai < 2; ++ai)
#pragma unroll
        for (int m = 0; m < 4; ++m) rs[ai][m] = 1.0f / sqrtf(parts_sum<NV4>(parts + (size_t)(row0 + ai * HALF + m * 16) * pitch, fq) * inv_dim + RMS_EPS);
}
__device__ __forceinline__ float sigmoidf_(float v) { return __builtin_amdgcn_rcpf(1.0f + __builtin_amdgcn_exp2f(-1.4426950408889634f * v)); }
typedef const f32x4 (&AccRef)[2][2][4][2];

struct EpiGateUp {
    static constexpr bool PERM = true, AFTER_DRAIN = false;
    bf16_t* H; int ldh; const float* ssq;
    __device__ __forceinline__ void operator()(AccRef acc, const Unit& u, int wr, int wc, int fr, int fq) const {
        asm volatile("" : "+v"(fr), "+v"(fq));
        const int row0 = u.pm * BM + wr * 64 + fr, col = u.pn * HALF + wc * 32 + 8 * fq;
        float rs[2][4]; unit_rstd<4>(rs, ssq, 16, row0, fq, 1.0f / 1024.0f);
#pragma unroll
        for (int ai = 0; ai < 2; ++ai)
#pragma unroll
            for (int m = 0; m < 4; ++m) { const float r = rs[ai][m]; f32x4 h[2];
#pragma unroll
                for (int n = 0; n < 2; ++n) { const f32x4 g = acc[ai][0][m][n] * r, up = acc[ai][1][m][n] * r;
#pragma unroll
                    for (int j = 0; j < 4; ++j) h[n][j] = g[j] * up[j] * sigmoidf_(g[j]); }
                *(u32x4*)(H + (size_t)(row0 + ai * HALF + m * 16) * ldh + col) = pack8(h[0], h[1]); asm volatile("" ::: "memory"); }
    }
};
struct EpiRes {
    static constexpr bool PERM = false, AFTER_DRAIN = false;
    const float* base; float* out; bf16_t* hb; float* ssq_out; float alpha;
    __device__ __forceinline__ void operator()(AccRef acc, const Unit& u, int wr, int wc, int fr, int fq) const {
        asm volatile("" : "+v"(fr), "+v"(fq));
        const int row0 = u.pm * BM + wr * 64 + fr, col0 = u.pn * BM + wc * 32 + 4 * fq;
#pragma unroll
        for (int ai = 0; ai < 2; ++ai)
#pragma unroll
            for (int m = 0; m < 4; ++m) { const int row = row0 + ai * HALF + m * 16; const size_t off = (size_t)row * 1024 + col0; float q = 0.f;
#pragma unroll
                for (int bj = 0; bj < 2; ++bj)
#pragma unroll
                    for (int n = 0; n < 2; ++n) { const size_t c = off + bj * HALF + n * 16; const f32x4 o = *(const f32x4*)(base + c) + acc[ai][bj][m][n] * alpha;
                        *(f32x4*)(out + c) = o; q += (o[0] * o[0] + o[1] * o[1]) + (o[2] * o[2] + o[3] * o[3]);
                        if (hb) *(u32x2*)(hb + c) = pack4(o); }
                q += __shfl_xor(q, 16); q += __shfl_xor(q, 32);
                if (ssq_out && fq == 0) ssq_out[(size_t)row * 16 + u.pn * 4 + wc] = q;
                if (m & 1) asm volatile("" ::: "memory"); }
    }
};
struct EpiLat {
    static constexpr bool PERM = true, AFTER_DRAIN = false;
    bf16_t* lat; float* ssql; bf16_t* KM; const float* cs; const float* ssq;
    __device__ __forceinline__ void operator()(AccRef acc, const Unit& u, int wr, int wc, int fr, int fq) const {
        asm volatile("" : "+v"(fr), "+v"(fq));
        const int row0 = u.pm * BM + wr * 64 + fr;
        float rs[2][4]; unit_rstd<4>(rs, ssq, 16, row0, fq, 1.0f / 1024.0f);
#pragma unroll
        for (int bj = 0; bj < 2; ++bj) { const int hh = 2 * u.pn + bj;
            if (hh < 5) {
#pragma unroll
                for (int ai = 0; ai < 2; ++ai)
#pragma unroll
                    for (int m = 0; m < 4; ++m) { const int row = row0 + ai * HALF + m * 16; const float r = rs[ai][m];
                        const f32x4 v0 = acc[ai][bj][m][0] * r, v1 = acc[ai][bj][m][1] * r;
                        float q = (v0[0] * v0[0] + v0[1] * v0[1]) + (v0[2] * v0[2] + v0[3] * v0[3]) + (v1[0] * v1[0] + v1[1] * v1[1]) + (v1[2] * v1[2] + v1[3] * v1[3]);
                        *(u32x4*)(lat + (size_t)row * 640 + hh * HALF + wc * 32 + 8 * fq) = pack8(v0, v1);
                        q += __shfl_xor(q, 16); q += __shfl_xor(q, 32);
                        if (fq == 0) ssql[(size_t)row * 32 + hh * 4 + wc] = q; asm volatile("" ::: "memory"); }
            } else if (wc == 0) {
#pragma unroll
                for (int ai = 0; ai < 2; ++ai)
#pragma unroll
                    for (int m = 0; m < 4; ++m) { const int row = row0 + ai * HALF + m * 16; const float r = rs[ai][m]; const int pos = row & 8191;
                        const f32x4 x1 = acc[ai][bj][m][0] * r, x2 = acc[ai][bj][m][1] * r;
                        const f32x4 co = *(const f32x4*)(cs + (size_t)pos * 32 + 4 * fq), si = *(const f32x4*)(cs + (size_t)pos * 32 + 16 + 4 * fq);
                        const u32x2 o1 = pack4(x1 * co - x2 * si), o2 = pack4(x1 * si + x2 * co);
                        bf16_t* kp = KM + (size_t)row * 768 + 64 + 4 * fq;
#pragma unroll
                        for (int h = 0; h < 8; ++h) { *(u32x2*)(kp + h * 96) = o1; *(u32x2*)(kp + h * 96 + 16) = o2; } asm volatile("" ::: "memory"); }
            }
        }
    }
};
struct EpiQup {
    static constexpr bool PERM = true, AFTER_DRAIN = false;
    bf16_t* QM; const float* ssql; const float* cs; float qscale;
    __device__ __forceinline__ void operator()(AccRef acc, const Unit& u, int wr, int wc, int fr, int fq) const {
        asm volatile("" : "+v"(fr), "+v"(fq));
        const int row0 = u.pm * BM + wr * 64 + fr;
        float rs[2][4]; unit_rstd<3>(rs, ssql, 32, row0, fq, 1.0f / 384.0f);
#pragma unroll
        for (int ai = 0; ai < 2; ++ai)
#pragma unroll
            for (int m = 0; m < 4; ++m) rs[ai][m] *= qscale;
#pragma unroll
        for (int bj = 0; bj < 2; ++bj) { const int s = 8 * u.pn + 4 * bj + wc; bf16_t* qp0 = QM + (size_t)row0 * 768 + 32 * s;
            if ((s % 3) != 2) {
#pragma unroll
                for (int ai = 0; ai < 2; ++ai)
#pragma unroll
                    for (int m = 0; m < 4; ++m) { const float r = rs[ai][m];
                        *(u32x4*)(qp0 + (size_t)(ai * HALF + m * 16) * 768 + 8 * fq) = pack8(acc[ai][bj][m][0] * r, acc[ai][bj][m][1] * r); asm volatile("" ::: "memory"); }
            } else {
                const float* cp0 = cs + (size_t)(row0 & 8191) * 32 + 4 * fq;
#pragma unroll
                for (int ai = 0; ai < 2; ++ai)
#pragma unroll
                    for (int m = 0; m < 4; ++m) { const float r = rs[ai][m]; const f32x4 x1 = acc[ai][bj][m][0] * r, x2 = acc[ai][bj][m][1] * r;
                        const float* cp = cp0 + (size_t)(ai * HALF + m * 16) * 32; const f32x4 co = *(const f32x4*)cp, si = *(const f32x4*)(cp + 16);
                        bf16_t* qp = qp0 + (size_t)(ai * HALF + m * 16) * 768;
                        *(u32x2*)(qp + 4 * fq) = pack4(x1 * co - x2 * si); *(u32x2*)(qp + 16 + 4 * fq) = pack4(x1 * si + x2 * co); asm volatile("" ::: "memory"); }
            }
        }
    }
};
struct EpiKVup {
    static constexpr bool PERM = true, AFTER_DRAIN = false;
    bf16_t* KM; bf16_t* VM; const float* ssql;
    __device__ __forceinline__ void operator()(AccRef acc, const Unit& u, int wr, int wc, int fr, int fq) const {
        asm volatile("" : "+v"(fr), "+v"(fq));
        const int row0 = u.pm * BM + wr * 64 + fr;
        float rs[2][4]; unit_rstd<2>(rs, ssql + 12, 32, row0, fq, 1.0f / 256.0f);
#pragma unroll
        for (int bj = 0; bj < 2; ++bj) { const int cw = u.pn * BM + bj * HALF + wc * 32;
            bf16_t* base; int pitch; if (cw < 512) { base = KM + (cw >> 6) * 96 + (cw & 63); pitch = 768; } else { base = VM + (cw - 512); pitch = 512; }
            base += (size_t)row0 * pitch + 8 * fq;
#pragma unroll
            for (int ai = 0; ai < 2; ++ai)
#pragma unroll
                for (int m = 0; m < 4; ++m) { const float r = rs[ai][m];
                    *(u32x4*)(base + (size_t)(ai * HALF + m * 16) * pitch) = pack8(acc[ai][bj][m][0] * r, acc[ai][bj][m][1] * r); asm volatile("" ::: "memory"); }
        }
    }
};
struct EpiProj {
    static constexpr bool PERM = true, AFTER_DRAIN = false;
    bf16_t* O; int ldo; const float* ssq; int sig_from; bf16_t* O2; int split_at; float qscale; int qtiles;
    __device__ __forceinline__ void operator()(AccRef acc, const Unit& u, int wr, int wc, int fr, int fq) const {
        asm volatile("" : "+v"(fr), "+v"(fq));
        const int row0 = u.pm * BM + wr * 64 + fr; const bool sig = u.pn >= sig_from;
        float rs[2][4];
        if (ssq) unit_rstd<4>(rs, ssq, 16, row0, fq, 1.0f / 1024.0f);
        else {
#pragma unroll
            for (int ai = 0; ai < 2; ++ai)
#pragma unroll
                for (int m = 0; m < 4; ++m) rs[ai][m] = 1.0f; }
        if (u.pn < qtiles) {
#pragma unroll
            for (int ai = 0; ai < 2; ++ai)
#pragma unroll
                for (int m = 0; m < 4; ++m) rs[ai][m] *= qscale; }
#pragma unroll
        for (int bj = 0; bj < 2; ++bj) { int c = u.pn * BM + bj * HALF + wc * 32 + 8 * fq; bf16_t* ob = O; if (c >= split_at) { c -= split_at; ob = O2; }
#pragma unroll
            for (int ai = 0; ai < 2; ++ai)
#pragma unroll
                for (int m = 0; m < 4; ++m) { const int row = row0 + ai * HALF + m * 16; const float r = rs[ai][m];
                    f32x4 v0 = acc[ai][bj][m][0] * r, v1 = acc[ai][bj][m][1] * r;
                    if (sig) {
#pragma unroll
                        for (int j = 0; j < 4; ++j) { v0[j] = sigmoidf_(v0[j]); v1[j] = sigmoidf_(v1[j]); } }
                    *(u32x4*)(ob + (size_t)row * ldo + c) = pack8(v0, v1); asm volatile("" ::: "memory"); }
        }
    }
};
template <int STEP> struct EpiBranch {
    static constexpr bool PERM = true, AFTER_DRAIN = false;
    bf16_t* PB;
    __device__ __forceinline__ void operator()(AccRef acc, const Unit& u, int wr, int wc, int fr, int fq) const {
        asm volatile("" : "+v"(fr), "+v"(fq));
        const int row0 = u.pm * BM + wr * 64 + fr;
#pragma unroll
        for (int bj = 0; bj < 2; ++bj) { const int c = u.pn * BM + bj * HALF + wc * 32 + 8 * fq;
#pragma unroll
            for (int ai = 0; ai < 2; ++ai)
#pragma unroll
                for (int m = 0; m < 4; ++m) { const int row = row0 + ai * HALF + m * 16; bf16_t* rp = PB + (size_t)row * 5120; float* tp = (float*)(rp + 1024) + c;
                    const u32x4 g = *(const u32x4*)(rp + (STEP == 0 ? 3072 : 4096) + c);
                    const f32x4 g0 = {bf_lo(g.x), bf_hi(g.x), bf_lo(g.y), bf_hi(g.y)}, g1 = {bf_lo(g.z), bf_hi(g.z), bf_lo(g.w), bf_hi(g.w)};
                    f32x4 v0 = acc[ai][bj][m][0] * g0, v1 = acc[ai][bj][m][1] * g1;
                    if (STEP == 0) { *(f32x4*)tp = v0; *(f32x4*)(tp + 4) = v1; }
                    else { v0 += *(const f32x4*)tp; v1 += *(const f32x4*)(tp + 4); *(u32x4*)(rp + 3072 + c) = pack8(v0, v1); }
                    asm volatile("" ::: "memory"); }
        }
    }
};
template <class Epi, class Sched, bool ALIGN_EPI = false, bool SP2 = false>
__device__ __forceinline__ void gemm_phase(PG8_LAS unsigned char* lds, const Gemm g, const Sched& S, const Epi& E) {
    int tid_ = threadIdx.x; asm volatile("" : "+v"(tid_));
    const int tid = tid_, wid = __builtin_amdgcn_readfirstlane(tid >> 6), lane = tid & 63, wr = wid >> 2, wc = wid & 3, fr = lane & 15, fq = lane >> 4;
    int K_ = g.K; asm volatile("" : "+s"(K_));
    const int K = K_, nt = K / BK;
    unsigned voffA, voffB;
    { int R, C; stage_rc(tid * 16, R, C); const int Rb = Epi::PERM ? ((R & ~31) + perm32(R & 31)) : R;
        voffA = (unsigned)(R * g.lda + C) * 2u; voffB = (unsigned)(Rb * K + C) * 2u; }
    const size_t r64A = (size_t)64 * g.lda * 2, r64B = (size_t)64 * K * 2;
    const size_t kstep = (size_t)(BK * 2);
    const size_t hstepA = (size_t)HALF * g.lda * 2, hstepB = (size_t)HALF * K * 2;
    const size_t tstepA = 2 * hstepA, tstepB = 2 * hstepB;
    const unsigned ldsw = (unsigned)wid * 1024u;
    const int aoff = lds_byte(wr * 64 + fr, fq * 8), boff = lds_byte(wc * 32 + fr, fq * 8);
#define PG8_SA(b, h) (((b) * 2 + (h)) * HTB)
#define PG8_SB(b, h) ((4 + (b) * 2 + (h)) * HTB)
#define PG8_STAGE(bufoff, gbase, W) do { _Pragma("unroll") for (int _i = 0; _i < 2; ++_i) \
        __builtin_amdgcn_global_load_lds((const unsigned*)((const char*)(gbase) + (size_t)_i * r64##W + voff##W), (PG8_LAS unsigned*)(lds + (bufoff) + ldsw + _i * 8192), 16, 0, 0); } while (0)
#define PG8_LDA(dst, b, h) do { _Pragma("unroll") for (int m = 0; m < 4; ++m) _Pragma("unroll") for (int k = 0; k < 2; ++k) dst[m][k] = *(const PG8_LAS bf16x8*)(lds + PG8_SA(b, h) + aoff + m * 2048 + k * 1024); } while (0)
#define PG8_LDB(dst, b, h) do { _Pragma("unroll") for (int n = 0; n < 2; ++n) _Pragma("unroll") for (int k = 0; k < 2; ++k) dst[n][k] = *(const PG8_LAS bf16x8*)(lds + PG8_SB(b, h) + boff + n * 2048 + k * 1024); } while (0)
#define PG8_MMA(ai, bj, At, Bt) do { __builtin_amdgcn_s_setprio(1); _Pragma("unroll") for (int m = 0; m < 4; ++m) _Pragma("unroll") for (int n = 0; n < 2; ++n) _Pragma("unroll") for (int k = 0; k < 2; ++k) \
        acc[ai][bj][m][n] = __builtin_amdgcn_mfma_f32_16x16x32_bf16(Bt[n][k], At[m][k], acc[ai][bj][m][n], 0, 0, 0); __builtin_amdgcn_s_setprio(0); } while (0)
#define PG8_WAIT_V(n) asm volatile("s_waitcnt vmcnt(" #n ")" ::: "memory")
#define PG8_WAIT_L(n) asm volatile("s_waitcnt lgkmcnt(" #n ")" ::: "memory")
#define PG8_BAR __builtin_amdgcn_s_barrier()
#define PG8_SCHED __builtin_amdgcn_sched_barrier(0)
    Unit cur, nxt; int ui = 0;
    if (!S.next(0, cur)) return;
    f32x4 acc[2][2][4][2];
#pragma unroll
    for (int a = 0; a < 2; ++a)
#pragma unroll
        for (int b = 0; b < 2; ++b)
#pragma unroll
            for (int m = 0; m < 4; ++m)
#pragma unroll
                for (int n = 0; n < 2; ++n) acc[a][b][m][n] = (f32x4){0.f, 0.f, 0.f, 0.f};
    bf16x8 At[4][2], B0[2][2], B1[2][2];
    const char* cA = (const char*)g.A + (size_t)cur.pm * tstepA; const char* cB = (const char*)g.Bt + (size_t)cur.pn * tstepB;
    S.a_ready(cur);
    if constexpr (SP2) {
        PG8_STAGE(PG8_SB(0, 0), cB, B); PG8_STAGE(PG8_SB(0, 1), cB + hstepB, B); PG8_STAGE(PG8_SA(0, 0), cA, A); PG8_STAGE(PG8_SA(0, 1), cA + hstepA, A);
        if (wr == 1) PG8_BAR;
        PG8_WAIT_V(2); PG8_BAR;
        PG8_STAGE(PG8_SB(1, 0), cB + kstep, B); PG8_STAGE(PG8_SA(1, 0), cA + kstep, A); PG8_STAGE(PG8_SB(1, 1), cB + hstepB + kstep, B);
        PG8_WAIT_V(6); PG8_BAR;
    } else {
        PG8_STAGE(PG8_SB(0, 0), cB, B); PG8_STAGE(PG8_SA(0, 0), cA, A); PG8_STAGE(PG8_SB(0, 1), cB + hstepB, B); PG8_STAGE(PG8_SA(0, 1), cA + hstepA, A);
        if (wr == 1) PG8_BAR;
        PG8_WAIT_V(4); PG8_BAR;
        PG8_STAGE(PG8_SB(1, 0), cB + kstep, B); PG8_STAGE(PG8_SA(1, 0), cA + kstep, A); PG8_STAGE(PG8_SB(1, 1), cB + hstepB + kstep, B);
        PG8_WAIT_V(6); PG8_BAR;
    }
    for (;;) {
        const bool has_next = S.next(ui + 1, nxt);
        const char* nA = has_next ? (const char*)g.A + (size_t)nxt.pm * tstepA : cA; const char* nB = has_next ? (const char*)g.Bt + (size_t)nxt.pn * tstepB : cB;
#pragma unroll 1
        for (int t = 0; t < nt; t += 2) {
            const bool last = (t == nt - 2);
            const char* a1 = cA + (size_t)(t + 1) * kstep;
            const char* a2 = last ? nA : cA + (size_t)(t + 2) * kstep; const char* b2 = last ? nB : cB + (size_t)(t + 2) * kstep;
            const char* a3 = a2 + kstep; const char* b3 = b2 + kstep;
            if (last && has_next) S.a_ready(nxt);
            if constexpr (SP2) {
            PG8_LDB(B0, 0, 0); PG8_LDB(B1, 0, 1); PG8_SCHED; PG8_LDA(At, 0, 0); PG8_STAGE(PG8_SA(1, 1), a1 + hstepA, A);
            PG8_WAIT_V(8); PG8_WAIT_L(0); PG8_BAR; PG8_MMA(0, 0, At, B0); PG8_MMA(0, 1, At, B1); PG8_BAR; PG8_SCHED;
            PG8_LDA(At, 0, 1); PG8_STAGE(PG8_SB(0, 0), b2, B); PG8_STAGE(PG8_SB(0, 1), b2 + hstepB, B); PG8_STAGE(PG8_SA(0, 0), a2, A);
            PG8_WAIT_V(8); PG8_WAIT_L(0); PG8_BAR; PG8_MMA(1, 0, At, B0); PG8_MMA(1, 1, At, B1); PG8_BAR; PG8_SCHED;
            PG8_LDB(B0, 1, 0); PG8_LDB(B1, 1, 1); PG8_SCHED; PG8_LDA(At, 1, 0); PG8_STAGE(PG8_SA(0, 1), a2 + hstepA, A);
            PG8_WAIT_V(8); PG8_WAIT_L(0); PG8_BAR; PG8_MMA(0, 0, At, B0); PG8_MMA(0, 1, At, B1); PG8_BAR; PG8_SCHED;
            PG8_LDA(At, 1, 1); PG8_STAGE(PG8_SB(1, 0), b3, B); PG8_STAGE(PG8_SB(1, 1), b3 + hstepB, B); PG8_STAGE(PG8_SA(1, 0), a3, A);
            PG8_WAIT_V(8); PG8_WAIT_L(0); PG8_BAR; PG8_MMA(1, 0, At, B0); PG8_MMA(1, 1, At, B1); PG8_BAR; PG8_SCHED;
            } else {
            PG8_LDB(B0, 0, 0); PG8_SCHED; PG8_LDA(At, 0, 0); PG8_STAGE(PG8_SA(1, 1), a1 + hstepA, A);
            PG8_WAIT_L(8); PG8_BAR; PG8_WAIT_L(0); PG8_MMA(0, 0, At, B0); PG8_BAR; PG8_SCHED;
            PG8_LDB(B1, 0, 1); PG8_STAGE(PG8_SB(0, 0), b2, B);
            PG8_BAR; PG8_WAIT_L(0); PG8_MMA(0, 1, At, B1); PG8_BAR;
            PG8_LDA(At, 0, 1); PG8_STAGE(PG8_SA(0, 0), a2, A);
            PG8_BAR; PG8_WAIT_L(0); PG8_MMA(1, 0, At, B0); PG8_BAR; PG8_SCHED;
            PG8_STAGE(PG8_SB(0, 1), b2 + hstepB, B);
            PG8_WAIT_V(6); PG8_BAR; PG8_MMA(1, 1, At, B1); PG8_BAR;
            PG8_LDB(B0, 1, 0); PG8_SCHED; PG8_LDA(At, 1, 0); PG8_STAGE(PG8_SA(0, 1), a2 + hstepA, A);
            PG8_WAIT_L(8); PG8_BAR; PG8_WAIT_L(0); PG8_MMA(0, 0, At, B0); PG8_BAR; PG8_SCHED;
            PG8_LDB(B1, 1, 1); PG8_STAGE(PG8_SB(1, 0), b3, B);
            PG8_BAR; PG8_WAIT_L(0); PG8_MMA(0, 1, At, B1); PG8_BAR;
            PG8_LDA(At, 1, 1); PG8_STAGE(PG8_SA(1, 0), a3, A);
            PG8_BAR; PG8_WAIT_L(0); PG8_MMA(1, 0, At, B0); PG8_BAR; PG8_SCHED;
            PG8_STAGE(PG8_SB(1, 1), b3 + hstepB, B);
            PG8_WAIT_V(6); PG8_BAR; PG8_MMA(1, 1, At, B1); PG8_BAR;
            }
        }
        if constexpr (ALIGN_EPI) { if (wr == 0) PG8_BAR; }
        if constexpr (!Epi::AFTER_DRAIN) { E(acc, cur, wr, wc, fr, fq); S.done(cur); }
        if (!has_next) break;
#pragma unroll
        for (int a = 0; a < 2; ++a)
#pragma unroll
            for (int b = 0; b < 2; ++b)
#pragma unroll
                for (int m = 0; m < 4; ++m)
#pragma unroll
                    for (int n = 0; n < 2; ++n) acc[a][b][m][n] = (f32x4){0.f, 0.f, 0.f, 0.f};
        cur = nxt; cA = nA; cB = nB; ++ui;
        if constexpr (ALIGN_EPI) { if (wr == 1) PG8_BAR; }
    }
    PG8_WAIT_V(0);
    if constexpr (!ALIGN_EPI) { if (wr == 0) PG8_BAR; }
    PG8_BAR;
    if constexpr (Epi::AFTER_DRAIN) { E.fused(acc, cur, wr, wc, fr, fq, lds, wid, lane); S.done(cur); }
#undef PG8_SA
#undef PG8_SB
#undef PG8_STAGE
#undef PG8_LDA
#undef PG8_LDB
#undef PG8_MMA
#undef PG8_WAIT_V
#undef PG8_WAIT_L
#undef PG8_BAR
#undef PG8_SCHED
}
}
namespace att {
typedef unsigned short bf16;
#define ATT_LAS __attribute__((address_space(3)))
using bf16x8 = __attribute__((ext_vector_type(8))) short;
using s16x4  = __attribute__((ext_vector_type(4))) short;
using f32x16 = __attribute__((ext_vector_type(16))) float;
using u32x4  = __attribute__((ext_vector_type(4))) unsigned;
typedef ATT_LAS char* lptr;
#define SBAR() __builtin_amdgcn_sched_barrier(0)
__device__ __forceinline__ int crow(int r, int hi) { return (r & 3) + 8 * (r >> 2) + 4 * hi; }
__device__ __forceinline__ unsigned cvtpk(float lo, float hi) { return pg8::cvt_pk_bf16(lo, hi); }
template <int DQK> __device__ __forceinline__ int kaddr(int row, int ch) { if constexpr (DQK == 64) return row * 128 + ((ch ^ ((row >> 1) & 7)) << 4); else return row * 256 + ((ch ^ (row & 15)) << 4); }
template <int NB> __device__ __forceinline__ int v_st(int k, int c) { const int kk = (k & ~0xC) | ((k & 4) << 1) | ((k & 8) >> 1); return ((kk >> 3) * NB + (c >> 5)) * 512 + ((kk & 7) * 32 + (c & 31)) * 2; }
__device__ __forceinline__ int v_rd_base(int lane) { return ((lane & 3) << 3) | (((lane >> 2) & 3) << 6) | (((lane >> 4) & 1) << 5) | (((lane >> 5) & 1) << 8); }
template <int NB> constexpr int v_rd_off(int d0, int ks, int half) { return ((2 * ks + half) * NB + d0) * 512; }
template <int OFF> __device__ __forceinline__ s16x4 tr_read(int vb) { s16x4 r; asm volatile("ds_read_b64_tr_b16 %0, %1 offset:%2" : "=&v"(r) : "v"(vb), "i"(OFF) : "memory"); return r; }
template <int NB, int D0> __device__ __forceinline__ void pv_one(f32x16& od, int vb, bf16x8 pa0, bf16x8 pa1, bf16x8 pa2, bf16x8 pa3) {
  const s16x4 l0 = tr_read<v_rd_off<NB>(D0, 0, 0)>(vb), h0 = tr_read<v_rd_off<NB>(D0, 0, 1)>(vb), l1 = tr_read<v_rd_off<NB>(D0, 1, 0)>(vb), h1 = tr_read<v_rd_off<NB>(D0, 1, 1)>(vb);
  const s16x4 l2 = tr_read<v_rd_off<NB>(D0, 2, 0)>(vb), h2 = tr_read<v_rd_off<NB>(D0, 2, 1)>(vb), l3 = tr_read<v_rd_off<NB>(D0, 3, 0)>(vb), h3 = tr_read<v_rd_off<NB>(D0, 3, 1)>(vb);
  asm volatile("s_waitcnt lgkmcnt(0)" ::: "memory"); SBAR();
#define ATT_PK(L, H) (bf16x8){L[0], L[1], L[2], L[3], H[0], H[1], H[2], H[3]}
  od = __builtin_amdgcn_mfma_f32_32x32x16_bf16(pa0, ATT_PK(l0, h0), od, 0, 0, 0);
  od = __builtin_amdgcn_mfma_f32_32x32x16_bf16(pa1, ATT_PK(l1, h1), od, 0, 0, 0);
  od = __builtin_amdgcn_mfma_f32_32x32x16_bf16(pa2, ATT_PK(l2, h2), od, 0, 0, 0);
  od = __builtin_amdgcn_mfma_f32_32x32x16_bf16(pa3, ATT_PK(l3, h3), od, 0, 0, 0);
#undef ATT_PK
}
template <int NB> __device__ __forceinline__ void pv_all(f32x16 (&o)[NB], int vb, bf16x8 pa0, bf16x8 pa1, bf16x8 pa2, bf16x8 pa3) {
  pv_one<NB, 0>(o[0], vb, pa0, pa1, pa2, pa3); pv_one<NB, 1>(o[1], vb, pa0, pa1, pa2, pa3);
  if constexpr (NB == 4) { pv_one<NB, 2>(o[2], vb, pa0, pa1, pa2, pa3); pv_one<NB, 3>(o[3], vb, pa0, pa1, pa2, pa3); }
}
template <int DQK> __device__ __forceinline__ void qkt(f32x16& p0, f32x16& p1, lptr Ks, const bf16x8 (&qr)[DQK / 16], int r32, int hi) {
  p0 = f32x16{}; p1 = f32x16{};
#pragma unroll
  for (int d0 = 0; d0 < DQK / 16; ++d0) {
    const bf16x8 b0 = *(const ATT_LAS bf16x8*)(Ks + kaddr<DQK>(r32, 2 * d0 + hi));
    const bf16x8 b1 = *(const ATT_LAS bf16x8*)(Ks + kaddr<DQK>(32 + r32, 2 * d0 + hi));
    p0 = __builtin_amdgcn_mfma_f32_32x32x16_bf16(b0, qr[d0], p0, 0, 0, 0);
    p1 = __builtin_amdgcn_mfma_f32_32x32x16_bf16(b1, qr[d0], p1, 0, 0, 0); }
}
template <bool BIAS> __device__ __forceinline__ void partialSM(f32x16& p0, f32x16& p1, float& m_reg, float& mn, float& alpha, const float C, const float thr_raw,
                                                               const bool masked, const bool biased, const ATT_LAS float* tb, const int relbase, const int hi) {
  if (masked) {
#pragma unroll
    for (int r = 0; r < 16; ++r) { p0[r] = -1e30f; p1[r] = -1e30f; }
  } else if (BIAS && biased) {
#pragma unroll
    for (int r = 0; r < 16; ++r) { const int i0 = relbase + crow(r, hi); p0[r] += tb[i0 < 0 ? 0 : i0]; p1[r] += tb[i0 + 32 < 0 ? 0 : i0 + 32]; }
  }
  float pmax = p0[0];
#pragma unroll
  for (int r = 1; r < 16; ++r) pmax = fmaxf(pmax, p0[r]);
#pragma unroll
  for (int r = 0; r < 16; ++r) pmax = fmaxf(pmax, p1[r]);
  { auto rr = __builtin_amdgcn_permlane32_swap(__float_as_uint(pmax), __float_as_uint(pmax), false, false);
    pmax = fmaxf(__uint_as_float(rr[0]), __uint_as_float(rr[1])); }
  if (__builtin_expect(__all(pmax - m_reg <= thr_raw), 1)) { mn = m_reg; alpha = 1.f; }
  else { mn = fmaxf(m_reg, pmax); alpha = __builtin_amdgcn_exp2f((m_reg - mn) * C); m_reg = mn; }
  const float mnC = -mn * C;
#pragma unroll
  for (int r = 0; r < 16; ++r) p0[r] = fmaf(p0[r], C, mnC);
#pragma unroll
  for (int r = 0; r < 16; ++r) p1[r] = fmaf(p1[r], C, mnC);
#pragma unroll
  for (int r = 0; r < 16; ++r) p0[r] = __builtin_amdgcn_exp2f(p0[r]);
}
__device__ __forceinline__ void finishSM(f32x16& p0, f32x16& p1, float alpha, float& l_reg, bf16x8& pa0, bf16x8& pa1, bf16x8& pa2, bf16x8& pa3) {
#pragma unroll
  for (int r = 0; r < 16; ++r) p1[r] = __builtin_amdgcn_exp2f(p1[r]);
  float ps = 0;
#pragma unroll
  for (int r = 0; r < 16; ++r) ps += p0[r];
#pragma unroll
  for (int r = 0; r < 16; ++r) ps += p1[r];
  { auto rr = __builtin_amdgcn_permlane32_swap(__float_as_uint(ps), __float_as_uint(ps), false, false);
    ps = __uint_as_float(rr[0]) + __uint_as_float(rr[1]); }
  l_reg = l_reg * alpha + ps;
#define ATT_PK4(P, BASE, OUT) do { unsigned a0 = cvtpk(P[BASE + 0], P[BASE + 1]), a1 = cvtpk(P[BASE + 2], P[BASE + 3]);   \
    unsigned b0 = cvtpk(P[BASE + 4], P[BASE + 5]), b1 = cvtpk(P[BASE + 6], P[BASE + 7]);                              \
    auto r0 = __builtin_amdgcn_permlane32_swap(a0, b0, false, false); auto r1 = __builtin_amdgcn_permlane32_swap(a1, b1, false, false); \
    u32x4 w = {r0[0], r1[0], r0[1], r1[1]}; OUT = __builtin_bit_cast(bf16x8, w); } while (0)
  ATT_PK4(p0, 0, pa0); ATT_PK4(p0, 8, pa1); ATT_PK4(p1, 0, pa2); ATT_PK4(p1, 8, pa3);
#undef ATT_PK4
}
template <int DQK, int DV> constexpr int core_lds() { return 2 * 64 * DV * 2 + 2 * 64 * (DQK == 64 ? 128 : 256) + 8 * 64 * 4; }

template <int DQK, int DV, int LDQ, int LDK, int LDV, bool CAUSAL, bool BIAS, int SD>
__device__ __forceinline__ void attn_core(const bf16* __restrict__ Qb, const bf16* __restrict__ Kh, const bf16* __restrict__ Vh, const int NT, const float C, const float thr_raw,
                                          const ATT_LAS float* tb, const int q0, lptr lds, f32x16 (&o)[DV / 32]) {
  constexpr int NB = DV / 32, ND = DQK / 16, KCH = DQK / 8, NKC = 64 * KCH, KIT = (NKC + 511) / 512, VCH = DV / 8, NVC = 64 * VCH, VIT = NVC / 512;
  constexpr int KBYTES = 64 * (DQK == 64 ? 128 : 256), VBYTES = 64 * DV * 2;
  int tid_ = threadIdx.x; asm volatile("" : "+v"(tid_));
  const int tid = tid_, lane = tid & 63, r32 = lane & 31, hi = lane >> 5; const int wid = __builtin_amdgcn_readfirstlane(tid >> 6);
  lptr V_lds = lds; lptr K_lds = lds + 2 * VBYTES;
  ATT_LAS float* ws = (ATT_LAS float*)(lds + 2 * VBYTES + 2 * KBYTES) + wid * 64; ATT_LAS float* li_l = ws; ATT_LAS float* al_l = ws + 32;
  float m_reg = -1e30f, l_reg = 0.f; bf16x8 qr[ND];
#pragma unroll
  for (int d = 0; d < NB; ++d) o[d] = f32x16{};
  const bf16* Qw = Qb + (long)(wid * 32 + r32) * LDQ + hi * 8;
#pragma unroll
  for (int d0 = 0; d0 < ND; ++d0) qr[d0] = *reinterpret_cast<const bf16x8*>(Qw + d0 * 16);
  int kg[KIT], kl[KIT], vg[VIT], vl[VIT];
#pragma unroll
  for (int it = 0; it < KIT; ++it) { const int idx = tid + 512 * it, row = idx / KCH, ch = idx % KCH; kg[it] = row * LDK + ch * 8; kl[it] = kaddr<DQK>(row & 63, ch); }
#pragma unroll
  for (int it = 0; it < VIT; ++it) { const int idx = tid + 512 * it, row = idx / VCH, ch = idx % VCH; vg[it] = row * LDV + ch * 8; vl[it] = v_st<NB>(row, ch * 8); }
  const int vb0 = (int)(unsigned)(uintptr_t)V_lds + v_rd_base(lane);
  struct { bf16x8 k[KIT]; bf16x8 v[VIT]; } sr_[SD];
  constexpr int SE = 0, SO = SD - 1;
#define SLOAD(i, k0) do { _Pragma("unroll") for (int it = 0; it < KIT; ++it) if (tid + 512 * it < NKC) sr_[i].k[it] = *reinterpret_cast<const bf16x8*>(Kh + (long)(k0) * LDK + kg[it]); \
    _Pragma("unroll") for (int it = 0; it < VIT; ++it) sr_[i].v[it] = *reinterpret_cast<const bf16x8*>(Vh + (long)(k0) * LDV + vg[it]); } while (0)
#define SWRITE(b, i) do { _Pragma("unroll") for (int it = 0; it < KIT; ++it) if (tid + 512 * it < NKC) *(ATT_LAS bf16x8*)(K_lds + (b) * KBYTES + kl[it]) = sr_[i].k[it]; \
    _Pragma("unroll") for (int it = 0; it < VIT; ++it) *(ATT_LAS bf16x8*)(V_lds + (b) * VBYTES + vl[it]) = sr_[i].v[it]; } while (0)
#define SWAIT() do { if constexpr (SD == 1) asm volatile("s_waitcnt vmcnt(0)" ::: "memory"); else if constexpr (NKC / 512 + VIT == 2) asm volatile("s_waitcnt vmcnt(2)" ::: "memory"); else if constexpr (NKC / 512 + VIT == 3) asm volatile("s_waitcnt vmcnt(3)" ::: "memory"); else asm volatile("s_waitcnt vmcnt(4)" ::: "memory"); } while (0)
#define RESC(a) do { if (__any((a) < 1.f)) { if (hi == 0) al_l[r32] = (a); asm volatile("s_waitcnt lgkmcnt(0)" ::: "memory"); \
    _Pragma("unroll") for (int d = 0; d < NB; ++d) _Pragma("unroll") for (int r = 0; r < 16; ++r) o[d][r] *= al_l[crow(r, hi)]; } } while (0)
#define TMASK(j) (CAUSAL && ((j) - (NT - 4)) > (wid >> 1))
#define TBIAS(j) (BIAS && (j) >= NT - 6)
#define RELB(j) (64 * (j) - (q0 + 32 * wid + r32) + 128)
  f32x16 pA0, pA1, pB0, pB1; float mnA, mnB, alA, alB; bf16x8 pa0, pa1, pa2, pa3;
  SLOAD(SE, 0); asm volatile("s_waitcnt vmcnt(0)" ::: "memory"); SWRITE(0, SE); __syncthreads();
  qkt<DQK>(pA0, pA1, K_lds, qr, r32, hi); partialSM<BIAS>(pA0, pA1, m_reg, mnA, alA, C, thr_raw, false, TBIAS(0), tb, RELB(0), hi);
  SLOAD(SO, 64); if constexpr (SD == 2) { if (2 < NT) SLOAD(SE, 128); }
  SWAIT(); SWRITE(1, SO); __syncthreads();
  for (int j = 1; j + 1 < NT; j += 2) {
    SBAR(); qkt<DQK>(pB0, pB1, K_lds + KBYTES, qr, r32, hi);
    finishSM(pA0, pA1, alA, l_reg, pa0, pa1, pa2, pa3); SBAR();
    SLOAD(SO, (j + SD) * 64); SBAR();
    pv_all<NB>(o, vb0, pa0, pa1, pa2, pa3); partialSM<BIAS>(pB0, pB1, m_reg, mnB, alB, C, thr_raw, TMASK(j), TBIAS(j), tb, RELB(j), hi);
    __syncthreads(); SWAIT(); SWRITE(0, SE);
    RESC(alB); __syncthreads();
    SBAR(); qkt<DQK>(pA0, pA1, K_lds, qr, r32, hi);
    finishSM(pB0, pB1, alB, l_reg, pa0, pa1, pa2, pa3); SBAR();
    if (SD == 1 || j + 3 < NT) SLOAD(SE, (j + 1 + SD) * 64); SBAR();
    pv_all<NB>(o, vb0 + VBYTES, pa0, pa1, pa2, pa3); partialSM<BIAS>(pA0, pA1, m_reg, mnA, alA, C, thr_raw, TMASK(j + 1), TBIAS(j + 1), tb, RELB(j + 1), hi);
    __syncthreads(); SWAIT(); SWRITE(1, SO);
    RESC(alA); __syncthreads();
  }
  SBAR(); qkt<DQK>(pB0, pB1, K_lds + KBYTES, qr, r32, hi);
  finishSM(pA0, pA1, alA, l_reg, pa0, pa1, pa2, pa3); SBAR();
  pv_all<NB>(o, vb0, pa0, pa1, pa2, pa3); partialSM<BIAS>(pB0, pB1, m_reg, mnB, alB, C, thr_raw, TMASK(NT - 1), TBIAS(NT - 1), tb, RELB(NT - 1), hi);
  __syncthreads(); RESC(alB);
  finishSM(pB0, pB1, alB, l_reg, pa0, pa1, pa2, pa3); SBAR();
  pv_all<NB>(o, vb0 + VBYTES, pa0, pa1, pa2, pa3);
  if (hi == 0) li_l[r32] = l_reg; asm volatile("s_waitcnt lgkmcnt(0)" ::: "memory");
#pragma unroll
  for (int r = 0; r < 16; ++r) { const float rl = __builtin_amdgcn_rcpf(li_l[crow(r, hi)]);
#pragma unroll
    for (int d = 0; d < NB; ++d) o[d][r] *= rl; }
  __syncthreads();
#undef SLOAD
#undef SWRITE
#undef SWAIT
#undef RESC
#undef TMASK
#undef TBIAS
#undef RELB
}
}
namespace att2 {
using att::bf16; using att::bf16x8; using att::s16x4; using att::f32x16; using att::u32x4; using att::lptr; using att::crow;
typedef short v4i16_t __attribute__((ext_vector_type(4)));
__device__ __forceinline__ void glds16(const void* gsrc, unsigned lds_dst) { unsigned keep;
  asm volatile("s_mov_b32 %0, m0\n\ts_mov_b32 m0, %2\n\ts_nop 0\n\tglobal_load_lds_dwordx4 %1, off\n\ts_mov_b32 m0, %0" : "=&s"(keep) : "v"(gsrc), "s"(lds_dst) : "memory"); }
__device__ __forceinline__ s16x4 vtr(ATT_LAS const char* p) { return __builtin_bit_cast(s16x4, __builtin_amdgcn_ds_read_tr16_b64_v4i16((ATT_LAS v4i16_t*)p)); }
#define A2_BAR() do { __builtin_amdgcn_sched_barrier(0); asm volatile("s_waitcnt lgkmcnt(0)\n\ts_barrier" ::: "memory"); __builtin_amdgcn_sched_barrier(0); } while (0)
template <int DQK, int DV> constexpr int core_lds() { return 3 * 64 * DQK * 2 + 3 * 64 * DV * 2 + 8 * 64 * 4; }

template <int DQK, int DV, int LDQ, int LDK, int LDV, bool CAUSAL, bool BIAS>
__device__ __forceinline__ void attn_core(const bf16* __restrict__ Qb, const bf16* __restrict__ Kh, const bf16* __restrict__ Vh, const int NT, const float C, const float thr_raw,
                                          const ATT_LAS float* tb, const int q0, lptr lds, f32x16 (&o)[DV / 32], const int dbg = 0) {
  constexpr int NB = DV / 32, ND = DQK / 16, NKP = DQK / 8, NVP = DV / 4 / 2 * 2 / 2;
  constexpr int KSLOT = 64 * DQK * 2, VSLOT = 64 * DV * 2;
  static_assert(NVP == DV / 8 && (NVP == 8 || NVP == 16) && NKP >= 8 && NKP <= 16, "piece counts");
  int tid_ = threadIdx.x; asm volatile("" : "+v"(tid_));
  const int tid = tid_, lane = tid & 63, r32 = lane & 31, hi = lane >> 5; const int wid = __builtin_amdgcn_readfirstlane(tid >> 6); const int half = wid >> 2;
  const unsigned lds0 = (unsigned)(uintptr_t)lds;
  lptr K_ring = lds, V_ring = lds + 3 * KSLOT;
  ATT_LAS float* ws = (ATT_LAS float*)(lds + 3 * KSLOT + 3 * VSLOT) + wid * 64; ATT_LAS float* li_l = ws; ATT_LAS float* al_l = ws + 32;
  const bf16* ksrc0 = Kh + (long)lane * LDK + wid * 8;
  const bf16* vsrc0 = Vh + (long)(16 * (wid & 3) + (lane >> 2)) * LDV + (wid >> 2) * 32 + (lane & 3) * 8;
  const unsigned kdst0 = lds0 + wid * 1024, vdst0 = lds0 + 3 * KSLOT + wid * 1024;
  const bool k2 = (wid + 8 < NKP);
#define A2_DMA_K(t, slot) do { glds16(ksrc0 + (long)(t) * 64 * LDK, (unsigned)__builtin_amdgcn_readfirstlane(kdst0 + (slot) * KSLOT)); \
    if (NKP > 8 && k2) glds16(ksrc0 + (long)(t) * 64 * LDK + 64, (unsigned)__builtin_amdgcn_readfirstlane(kdst0 + (slot) * KSLOT + 8192)); } while (0)
#define A2_DMA_V(t, slot) do { glds16(vsrc0 + (long)(t) * 64 * LDV, (unsigned)__builtin_amdgcn_readfirstlane(vdst0 + (slot) * VSLOT)); \
    if (NVP > 8) glds16(vsrc0 + (long)(t) * 64 * LDV + 64, (unsigned)__builtin_amdgcn_readfirstlane(vdst0 + (slot) * VSLOT + 8192)); } while (0)
#define A2_WAITN() do { if constexpr (NKP == 8 && NVP == 8) asm volatile("s_waitcnt vmcnt(2)" ::: "memory"); \
    else if constexpr (NKP == 8 && NVP == 16) asm volatile("s_waitcnt vmcnt(3)" ::: "memory"); \
    else if constexpr (NKP == 16 && NVP == 16) asm volatile("s_waitcnt vmcnt(4)" ::: "memory"); \
    else { if (k2) asm volatile("s_waitcnt vmcnt(3)" ::: "memory"); else asm volatile("s_waitcnt vmcnt(2)" ::: "memory"); } } while (0)
  static_assert((NKP == 8 || NKP == 16 || (NKP == 12 && NVP == 8)), "wait counts cover these shapes");
  const unsigned kb0 = lds0 + hi * 1024 + r32 * 16;
  const unsigned vb0 = lds0 + 3 * KSLOT + ((lane >> 4) & 1) * 32 + (lane & 3) * 8 + (4 * hi + ((lane & 15) >> 2)) * 64;
  A2_DMA_K(0, 0); A2_DMA_V(0, 0); if (1 < NT) A2_DMA_K(1, 1);
  bf16x8 qr[ND];
  { const bf16* Qw = Qb + (long)(wid * 32 + r32) * LDQ + hi * 8;
#pragma unroll
    for (int d0 = 0; d0 < ND; ++d0) qr[d0] = *reinterpret_cast<const bf16x8*>(Qw + d0 * 16);
#pragma unroll
    for (int d0 = 0; d0 < ND; ++d0) asm volatile("" : "+v"(qr[d0])); }
#pragma unroll
  for (int d = 0; d < NB; ++d) o[d] = f32x16{};
  float m_reg = -1e30f, l_reg = 0.f; f32x16 p0, p1; bf16x8 pa[4];
  asm volatile("s_waitcnt vmcnt(0)" ::: "memory"); A2_BAR();
#define A2_KRD(kbv) do { _Pragma("unroll") for (int d0 = 0; d0 < ND; ++d0) { \
      asm volatile("ds_read_b128 %0, %1 offset:%2" : "=&v"(kf[2 * d0]) : "v"(kbv), "i"(d0 * 2048) : "memory"); \
      asm volatile("ds_read_b128 %0, %1 offset:%2" : "=&v"(kf[2 * d0 + 1]) : "v"(kbv), "i"(d0 * 2048 + 512) : "memory"); } } while (0)
#define A2_VRD(buf, vbv, dh) do { _Pragma("unroll") for (int ks = 0; ks < 4; ++ks) { \
      asm volatile("ds_read_b64_tr_b16 %0, %1 offset:%2" : "=&v"(vl##buf[ks]) : "v"(vbv), "i"((dh) * 4096 + ks * 1024) : "memory"); \
      asm volatile("ds_read_b64_tr_b16 %0, %1 offset:%2" : "=&v"(vh##buf[ks]) : "v"(vbv), "i"((dh) * 4096 + ks * 1024 + 512) : "memory"); } } while (0)
#define A2_LW(n) do { asm volatile("s_waitcnt lgkmcnt(" #n ")" ::: "memory"); __builtin_amdgcn_sched_barrier(0); } while (0)
#define A2_QKM() do { p0 = f32x16{}; p1 = f32x16{}; _Pragma("unroll") for (int d0 = 0; d0 < ND; ++d0) { \
      p0 = __builtin_amdgcn_mfma_f32_32x32x16_bf16(kf[2 * d0], qr[d0], p0, 0, 0, 0); p1 = __builtin_amdgcn_mfma_f32_32x32x16_bf16(kf[2 * d0 + 1], qr[d0], p1, 0, 0, 0); } } while (0)
#define A2_PVM(buf, dh) do { _Pragma("unroll") for (int ks = 0; ks < 4; ++ks) \
      o[dh] = __builtin_amdgcn_mfma_f32_32x32x16_bf16(pa[ks], (bf16x8){vl##buf[ks][0], vl##buf[ks][1], vl##buf[ks][2], vl##buf[ks][3], vh##buf[ks][0], vh##buf[ks][1], vh##buf[ks][2], vh##buf[ks][3]}, o[dh], 0, 0, 0); } while (0)
#define A2_SB() __builtin_amdgcn_sched_barrier(0)
#define A2_QKM1(d0) do { p0 = __builtin_amdgcn_mfma_f32_32x32x16_bf16(kf[2 * (d0)], qr[d0], p0, 0, 0, 0); p1 = __builtin_amdgcn_mfma_f32_32x32x16_bf16(kf[2 * (d0) + 1], qr[d0], p1, 0, 0, 0); } while (0)
#define A2_VRD1(buf, vbv, dh, ks) do { \
      asm volatile("ds_read_b64_tr_b16 %0, %1 offset:%2" : "=&v"(vl##buf[ks]) : "v"(vbv), "i"((dh) * 4096 + (ks) * 1024) : "memory"); \
      asm volatile("ds_read_b64_tr_b16 %0, %1 offset:%2" : "=&v"(vh##buf[ks]) : "v"(vbv), "i"((dh) * 4096 + (ks) * 1024 + 512) : "memory"); } while (0)
#define A2_LWV(n) do { asm volatile("s_waitcnt lgkmcnt(%0)" :: "i"(n) : "memory"); __builtin_amdgcn_sched_barrier(0); } while (0)
#define A2_PVREST(vbv) do { A2_LW(0); A2_VRD(B, vbv, 1); A2_PVM(A, 0); A2_SB(); \
    if constexpr (NB > 2) { A2_LW(0); A2_VRD(A, vbv, 2); A2_PVM(B, 1); A2_SB(); A2_LW(0); A2_VRD(B, vbv, 3); A2_PVM(A, 2); A2_SB(); A2_LW(0); A2_PVM(B, 3); A2_SB(); } \
    else { A2_LW(0); A2_PVM(B, 1); A2_SB(); } } while (0)
#define A2_M_Q(tq) do { __builtin_amdgcn_s_setprio(1); bf16x8 kf[2 * ND]; const unsigned kbv_ = kb0 + ((tq) % 3) * KSLOT; A2_KRD(kbv_); p0 = f32x16{}; p1 = f32x16{}; \
    _Pragma("unroll") for (int d0 = 0; d0 < ND; ++d0) { A2_LWV(2 * ND - 2 * d0 - 2); A2_QKM1(d0); A2_SB(); } __builtin_amdgcn_s_setprio(0); } while (0)
#define A2_M_P(tv) do { __builtin_amdgcn_s_setprio(1); s16x4 vlA[4], vhA[4], vlB[4], vhB[4]; const unsigned vbv_ = vb0 + ((tv) % 3) * VSLOT; A2_VRD(A, vbv_, 0); A2_PVREST(vbv_); __builtin_amdgcn_s_setprio(0); } while (0)
#define A2_M_QP(tq, tv) do { bf16x8 kf[2 * ND]; s16x4 vlA[4], vhA[4], vlB[4], vhB[4]; const unsigned kbv_ = kb0 + ((tq) % 3) * KSLOT, vbv_ = vb0 + ((tv) % 3) * VSLOT; \
    A2_KRD(kbv_); p0 = f32x16{}; p1 = f32x16{}; \
    _Pragma("unroll") for (int d0 = 0; d0 < ND; ++d0) { A2_LWV((2 * ND - 2 * d0 - 2) + (2 * d0 < 8 ? 2 * d0 : 8)); A2_QKM1(d0); A2_SB(); if (d0 < 4) { A2_VRD1(A, vbv_, 0, d0); } A2_SB(); } \
    A2_PVREST(vbv_); } while (0)
#define A2_SOFT(t) do { const int t_ = (t); \
    if (CAUSAL && (t_ - (NT - 4)) > (wid >> 1)) { _Pragma("unroll") for (int r = 0; r < 16; ++r) { p0[r] = -1e30f; p1[r] = -1e30f; } } \
    else if (BIAS && t_ >= NT - 6) { const int rb_ = 64 * t_ - (q0 + 32 * wid + r32) + 128; \
      _Pragma("unroll") for (int r = 0; r < 16; ++r) { const int i0 = rb_ + crow(r, hi); p0[r] += tb[i0 < 0 ? 0 : i0]; p1[r] += tb[i0 + 32 < 0 ? 0 : i0 + 32]; } } \
    float pmax = p0[0]; \
    _Pragma("unroll") for (int r = 1; r < 16; ++r) pmax = fmaxf(pmax, p0[r]); \
    _Pragma("unroll") for (int r = 0; r < 16; ++r) pmax = fmaxf(pmax, p1[r]); \
    { auto rr = __builtin_amdgcn_permlane32_swap(__float_as_uint(pmax), __float_as_uint(pmax), false, false); pmax = fmaxf(__uint_as_float(rr[0]), __uint_as_float(rr[1])); } \
    float alpha = 1.f; \
    if (!__builtin_expect(__all(pmax - m_reg <= thr_raw), 1)) { const float mn = fmaxf(m_reg, pmax); alpha = __builtin_amdgcn_exp2f((m_reg - mn) * C); m_reg = mn; \
      if (hi == 0) al_l[r32] = alpha; asm volatile("s_waitcnt lgkmcnt(0)" ::: "memory"); \
      _Pragma("unroll") for (int d = 0; d < NB; ++d) _Pragma("unroll") for (int r = 0; r < 16; ++r) o[d][r] *= al_l[crow(r, hi)]; } \
    const float mnC = -m_reg * C; float ps = 0.f; \
    _Pragma("unroll") for (int r = 0; r < 16; ++r) { p0[r] = __builtin_amdgcn_exp2f(fmaf(p0[r], C, mnC)); p1[r] = __builtin_amdgcn_exp2f(fmaf(p1[r], C, mnC)); } \
    _Pragma("unroll") for (int r = 0; r < 16; ++r) ps += p0[r] + p1[r]; \
    { auto rr = __builtin_amdgcn_permlane32_swap(__float_as_uint(ps), __float_as_uint(ps), false, false); ps = __uint_as_float(rr[0]) + __uint_as_float(rr[1]); } \
    l_reg = l_reg * alpha + ps; \
    { u32x4 w0 = {att::cvtpk(p0[0], p0[1]), att::cvtpk(p0[2], p0[3]), att::cvtpk(p0[4], p0[5]), att::cvtpk(p0[6], p0[7])}; pa[0] = __builtin_bit_cast(bf16x8, w0); \
      u32x4 w1 = {att::cvtpk(p0[8], p0[9]), att::cvtpk(p0[10], p0[11]), att::cvtpk(p0[12], p0[13]), att::cvtpk(p0[14], p0[15])}; pa[1] = __builtin_bit_cast(bf16x8, w1); \
      u32x4 w2 = {att::cvtpk(p1[0], p1[1]), att::cvtpk(p1[2], p1[3]), att::cvtpk(p1[4], p1[5]), att::cvtpk(p1[6], p1[7])}; pa[2] = __builtin_bit_cast(bf16x8, w2); \
      u32x4 w3 = {att::cvtpk(p1[8], p1[9]), att::cvtpk(p1[10], p1[11]), att::cvtpk(p1[12], p1[13]), att::cvtpk(p1[14], p1[15])}; pa[3] = __builtin_bit_cast(bf16x8, w3); } } while (0)
#define A2_ISSUE(u) do { if (!(dbg & 1)) { if ((u) + 2 < NT) A2_DMA_K((u) + 2, ((u) + 2) % 3); if ((u) + 1 < NT) A2_DMA_V((u) + 1, ((u) + 1) % 3); } } while (0)
#define A2_ENDODD(t) do { if ((t) + 3 < NT) A2_WAITN(); else asm volatile("s_waitcnt vmcnt(0)" ::: "memory"); A2_BAR(); } while (0)
  if (half == 0) {
    A2_ISSUE(0); A2_M_Q(0); A2_BAR();
#pragma unroll 1
    for (int t = 0; t < NT; ++t) {
      if (!(dbg & 2)) { A2_SOFT(t); } A2_ENDODD(t);
      A2_ISSUE(t + 1);
      if (!(dbg & 4)) { if (t + 1 < NT) { A2_M_Q(t + 1); } A2_M_P(t); }
      A2_BAR();
    }
    A2_BAR();
  } else {
    A2_ISSUE(0); A2_BAR();
#pragma unroll 1
    for (int t = 0; t < NT; ++t) {
      if (!(dbg & 4)) { A2_M_Q(t); if (t > 0) { A2_M_P(t - 1); } } A2_ENDODD(t);
      A2_ISSUE(t + 1); if (!(dbg & 2)) { A2_SOFT(t); } A2_BAR();
    }
    A2_M_P(NT - 1); A2_BAR();
  }
  if (hi == 0) li_l[r32] = l_reg; asm volatile("s_waitcnt lgkmcnt(0)" ::: "memory");
#pragma unroll
  for (int r = 0; r < 16; ++r) { const float rl = __builtin_amdgcn_rcpf(li_l[crow(r, hi)]);
#pragma unroll
    for (int d = 0; d < NB; ++d) o[d][r] *= rl; }
#undef A2_DMA_K
#undef A2_DMA_V
#undef A2_WAITN
#undef A2_KRD
#undef A2_VRD
#undef A2_LW
#undef A2_QKM
#undef A2_PVM
#undef A2_SB
#undef A2_QKM1
#undef A2_VRD1
#undef A2_LWV
#undef A2_PVREST
#undef A2_M_Q
#undef A2_M_P
#undef A2_M_QP
#undef A2_SOFT
#undef A2_ISSUE
#undef A2_ENDODD
}
}
namespace att3 {
using att::bf16; using att::bf16x8; using att::s16x4; using att::f32x16; using att::u32x4; using att::lptr; using att::crow;
using att2::glds16; using att2::vtr;
template <int DQK, int DV> constexpr int core_lds() { return 3 * 64 * DQK * 2 + 3 * 64 * DV * 2 + 8 * 64 * 4; }
#define A3_SB() __builtin_amdgcn_sched_barrier(0)
#define A3_SGB(mask, n) __builtin_amdgcn_sched_group_barrier(mask, n, 0)

template <int DQK, int DV, int LDQ, int LDK, int LDV, bool CAUSAL, bool BIAS>
__device__ __forceinline__ void attn_core(const bf16* __restrict__ Qb, const bf16* __restrict__ Kh, const bf16* __restrict__ Vh, const int NT, const float C, const float thr_raw,
                                          const ATT_LAS float* tb, const int q0, lptr lds, f32x16 (&o)[DV / 32], const int dbg = 0) {
  constexpr int NB = DV / 32, ND = DQK / 16, NKP = DQK / 8, NVP = DV / 8;
  constexpr int KSLOT = 64 * DQK * 2, VSLOT = 64 * DV * 2;
  static_assert((NVP == 8 || NVP == 16) && (NKP == 8 || NKP == 12 || NKP == 16), "piece counts");
  int tid_ = threadIdx.x; asm volatile("" : "+v"(tid_));
  const int tid = tid_, lane = tid & 63, r32 = lane & 31, hi = lane >> 5; const int wid = __builtin_amdgcn_readfirstlane(tid >> 6);
  const unsigned lds0 = (unsigned)(uintptr_t)lds;
  ATT_LAS float* ws = (ATT_LAS float*)(lds + 3 * KSLOT + 3 * VSLOT) + wid * 64; ATT_LAS float* li_l = ws; ATT_LAS float* al_l = ws + 32;
  const bf16* ksrc0 = Kh + (long)lane * LDK + wid * 8;
  const bf16* vsrc0 = Vh + (long)(16 * (wid & 3) + (lane >> 2)) * LDV + (wid >> 2) * 32 + (lane & 3) * 8;
  const unsigned kdst0 = lds0 + wid * 1024, vdst0 = lds0 + 3 * KSLOT + wid * 1024;
  const bool k2 = (wid + 8 < NKP);
#define A3_DMA_K(t, slot) do { glds16(ksrc0 + (long)(t) * 64 * LDK, (unsigned)__builtin_amdgcn_readfirstlane(kdst0 + (slot) * KSLOT)); \
    if (NKP > 8 && k2) glds16(ksrc0 + (long)(t) * 64 * LDK + 64, (unsigned)__builtin_amdgcn_readfirstlane(kdst0 + (slot) * KSLOT + 8192)); } while (0)
#define A3_DMA_V(t, slot) do { glds16(vsrc0 + (long)(t) * 64 * LDV, (unsigned)__builtin_amdgcn_readfirstlane(vdst0 + (slot) * VSLOT)); \
    if (NVP > 8) glds16(vsrc0 + (long)(t) * 64 * LDV + 64, (unsigned)__builtin_amdgcn_readfirstlane(vdst0 + (slot) * VSLOT + 8192)); } while (0)
#define A3_WAITN() do { if constexpr (NKP == 8 && NVP == 8) asm volatile("s_waitcnt vmcnt(2)" ::: "memory"); \
    else if constexpr (NKP == 8 && NVP == 16) asm volatile("s_waitcnt vmcnt(3)" ::: "memory"); \
    else if constexpr (NKP == 16 && NVP == 16) asm volatile("s_waitcnt vmcnt(4)" ::: "memory"); \
    else if constexpr (NKP == 16 && NVP == 8) asm volatile("s_waitcnt vmcnt(3)" ::: "memory"); \
    else if constexpr (NVP == 8) { if (k2) asm volatile("s_waitcnt vmcnt(3)" ::: "memory"); else asm volatile("s_waitcnt vmcnt(2)" ::: "memory"); } \
    else { if (k2) asm volatile("s_waitcnt vmcnt(4)" ::: "memory"); else asm volatile("s_waitcnt vmcnt(3)" ::: "memory"); } } while (0)
  const unsigned kb0 = lds0 + hi * 1024 + r32 * 16;
  const unsigned vb0 = lds0 + 3 * KSLOT + ((lane >> 4) & 1) * 32 + (lane & 3) * 8 + (4 * hi + ((lane & 15) >> 2)) * 64;
  A3_DMA_K(0, 0); A3_DMA_V(0, 0); if (1 < NT) { A3_DMA_K(1, 1); A3_DMA_V(1, 1); } if (2 < NT) A3_DMA_K(2, 2);
  bf16x8 qr[ND];
  { const bf16* Qw = Qb + (long)(wid * 32 + r32) * LDQ + hi * 8;
#pragma unroll
    for (int d0 = 0; d0 < ND; ++d0) qr[d0] = *reinterpret_cast<const bf16x8*>(Qw + d0 * 16);
#pragma unroll
    for (int d0 = 0; d0 < ND; ++d0) asm volatile("" : "+v"(qr[d0])); }
#pragma unroll
  for (int d = 0; d < NB; ++d) o[d] = f32x16{};
  float mhat = 0.f, fresc = 1.f; bool resc = false;
  f32x16 pA0, pA1, pB0, pB1; bf16x8 pa[4]; f32x16 negm = f32x16{}, ol = f32x16{};
  const bf16x8 ones = {0x3F80, 0x3F80, 0x3F80, 0x3F80, 0x3F80, 0x3F80, 0x3F80, 0x3F80};
  asm volatile("s_waitcnt vmcnt(0) lgkmcnt(0)\n\ts_barrier" ::: "memory");
#define A3_QK(C0, C1, t) do { unsigned kbv_ = kb0 + ((t) % 3) * KSLOT; asm volatile("" : "+v"(kbv_)); \
    _Pragma("unroll") for (int d0 = 0; d0 < ND; ++d0) { const bf16x8 b0_ = *(const ATT_LAS bf16x8*)(uintptr_t)(kbv_ + d0 * 2048), b1_ = *(const ATT_LAS bf16x8*)(uintptr_t)(kbv_ + d0 * 2048 + 512); \
      if (d0 == 0) { C0 = __builtin_amdgcn_mfma_f32_32x32x16_bf16(b0_, qr[0], negm, 0, 0, 0); C1 = __builtin_amdgcn_mfma_f32_32x32x16_bf16(b1_, qr[0], negm, 0, 0, 0); } \
      else { C0 = __builtin_amdgcn_mfma_f32_32x32x16_bf16(b0_, qr[d0], C0, 0, 0, 0); C1 = __builtin_amdgcn_mfma_f32_32x32x16_bf16(b1_, qr[d0], C1, 0, 0, 0); } } } while (0)
#define A3_FIN(P0, P1) do { \
    { u32x4 w0 = {att::cvtpk(P0[0], P0[1]), att::cvtpk(P0[2], P0[3]), att::cvtpk(P0[4], P0[5]), att::cvtpk(P0[6], P0[7])}; pa[0] = __builtin_bit_cast(bf16x8, w0); \
      u32x4 w1 = {att::cvtpk(P0[8], P0[9]), att::cvtpk(P0[10], P0[11]), att::cvtpk(P0[12], P0[13]), att::cvtpk(P0[14], P0[15])}; pa[1] = __builtin_bit_cast(bf16x8, w1); \
      u32x4 w2 = {att::cvtpk(P1[0], P1[1]), att::cvtpk(P1[2], P1[3]), att::cvtpk(P1[4], P1[5]), att::cvtpk(P1[6], P1[7])}; pa[2] = __builtin_bit_cast(bf16x8, w2); \
      u32x4 w3 = {att::cvtpk(P1[8], P1[9]), att::cvtpk(P1[10], P1[11]), att::cvtpk(P1[12], P1[13]), att::cvtpk(P1[14], P1[15])}; pa[3] = __builtin_bit_cast(bf16x8, w3); } } while (0)
#define A3_MID(C0, C1, t, FIRST) do { const int t_ = (t); \
    if (CAUSAL && (t_ - (NT - 4)) > (wid >> 1)) { _Pragma("unroll") for (int r = 0; r < 16; ++r) { C0[r] = -1e30f; C1[r] = -1e30f; } } \
    else if (BIAS && t_ >= NT - 6) { const int rb_ = 64 * t_ - (q0 + 32 * wid + r32) + 128; \
      _Pragma("unroll") for (int r = 0; r < 16; ++r) { const int i0 = rb_ + crow(r, hi); C0[r] += tb[i0 < 0 ? 0 : i0]; C1[r] += tb[i0 + 32 < 0 ? 0 : i0 + 32]; } } \
    float pmax = C0[0]; \
    _Pragma("unroll") for (int r = 1; r < 16; ++r) pmax = fmaxf(pmax, C0[r]); \
    _Pragma("unroll") for (int r = 0; r < 16; ++r) pmax = fmaxf(pmax, C1[r]); \
    { auto rr = __builtin_amdgcn_permlane32_swap(__float_as_uint(pmax), __float_as_uint(pmax), false, false); pmax = fmaxf(__uint_as_float(rr[0]), __uint_as_float(rr[1])); } \
    resc = false; \
    if (FIRST || !__builtin_expect(__all(pmax <= thr_raw), 1)) { const float dl = FIRST ? pmax : fmaxf(pmax, 0.f); mhat += dl; \
      _Pragma("unroll") for (int r = 0; r < 16; ++r) { C0[r] -= dl; C1[r] -= dl; } \
      _Pragma("unroll") for (int r = 0; r < 16; ++r) negm[r] = -mhat; \
      if (!FIRST) { fresc = __builtin_amdgcn_exp2f(-dl); if (hi == 0) al_l[r32] = fresc; resc = true; } } } while (0)
#define A3_PVEXP(DOPV, tv, DOEXP, C0, C1) do { unsigned vbv_ = vb0 + ((tv) % 3) * VSLOT; asm volatile("" : "+v"(vbv_)); \
    if (DOPV) { _Pragma("unroll") for (int dh = 0; dh < NB; ++dh) _Pragma("unroll") for (int ks = 0; ks < 4; ++ks) { \
      const s16x4 lo_ = vtr((ATT_LAS const char*)(uintptr_t)(vbv_ + dh * 4096 + ks * 1024)), hi_ = vtr((ATT_LAS const char*)(uintptr_t)(vbv_ + dh * 4096 + ks * 1024 + 512)); \
      o[dh] = __builtin_amdgcn_mfma_f32_32x32x16_bf16(pa[ks], __builtin_shufflevector(lo_, hi_, 0, 1, 2, 3, 4, 5, 6, 7), o[dh], 0, 0, 0); } \
      _Pragma("unroll") for (int ks = 0; ks < 4; ++ks) ol = __builtin_amdgcn_mfma_f32_32x32x16_bf16(pa[ks], ones, ol, 0, 0, 0); } \
    if (DOEXP) { _Pragma("unroll") for (int r = 0; r < 16; ++r) { C0[r] = __builtin_amdgcn_exp2f(C0[r]); C1[r] = __builtin_amdgcn_exp2f(C1[r]); } } } while (0)
#define A3_PIN4() asm volatile("" : "+v"(pa[0]), "+v"(pa[1]), "+v"(pa[2]), "+v"(pa[3]))
#define A3_RESC() do { if (resc) { asm volatile("s_waitcnt lgkmcnt(0)" ::: "memory"); \
    _Pragma("unroll") for (int r = 0; r < 16; ++r) { const float f_ = al_l[crow(r, hi)]; ol[r] *= f_; _Pragma("unroll") for (int d = 0; d < NB; ++d) o[d][r] *= f_; } } } while (0)
#define A3_END(t) do { A3_SB(); if ((t) + 2 < NT) A3_WAITN(); else asm volatile("s_waitcnt vmcnt(0)" ::: "memory"); asm volatile("s_waitcnt lgkmcnt(0)\n\ts_barrier" ::: "memory"); A3_SB(); \
    if (!(dbg & 1)) { if ((t) + 3 < NT) A3_DMA_K((t) + 3, (t) % 3); if ((t) + 2 < NT) A3_DMA_V((t) + 2, ((t) + 2) % 3); } A3_RESC(); } while (0)
#define A3_MIX(npre, nm, nv, nd) do { A3_SGB(0x100, npre); _Pragma("unroll") for (int i_ = 0; i_ < (nm); ++i_) { A3_SGB(0x008, 1); if ((nd) > 0) A3_SGB(0x100, nd); A3_SGB(0x002, nv); } } while (0)
#define A3_STEP(C0, C1, P0, P1, t) do { \
    A3_SB(); if (!(dbg & 4)) { A3_QK(C0, C1, t); } A3_FIN(P0, P1); A3_PIN4(); A3_MIX(2 * ND, 2 * ND, (16 + 2 * ND - 1) / (2 * ND), 0); A3_SB(); \
    if (!(dbg & 16)) { A3_MID(C0, C1, t, false); } A3_SB(); \
    A3_PVEXP(!(dbg & 8), (t) - 1, !(dbg & 2), C0, C1); asm volatile("" : "+v"(C0), "+v"(C1)); A3_MIX(8, 4 * NB + 4, (32 + 4 * NB + 3) / (4 * NB + 4), 2); \
    A3_END(t); } while (0)
  A3_SB(); A3_QK(pA0, pA1, 0); A3_SB(); A3_MID(pA0, pA1, 0, true); A3_SB(); A3_PVEXP(false, 0, true, pA0, pA1); A3_END(0);
  int t = 1;
#pragma unroll 1
  for (; t + 1 < NT; t += 2) { A3_STEP(pB0, pB1, pA0, pA1, t); A3_STEP(pA0, pA1, pB0, pB1, t + 1); }
  A3_STEP(pB0, pB1, pA0, pA1, t);
  A3_SB(); A3_FIN(pB0, pB1); A3_SB(); A3_PVEXP(true, NT - 1, false, pB0, pB1); A3_SB();
#pragma unroll
  for (int r = 0; r < 16; ++r) { const float rl = __builtin_amdgcn_rcpf(ol[r]);
#pragma unroll
    for (int d = 0; d < NB; ++d) o[d][r] *= rl; }
  asm volatile("s_waitcnt lgkmcnt(0)\n\ts_barrier" ::: "memory");
#undef A3_DMA_K
#undef A3_DMA_V
#undef A3_WAITN
#undef A3_QK
#undef A3_FIN
#undef A3_MID
#undef A3_PVEXP
#undef A3_RESC
#undef A3_PIN4
#undef A3_END
#undef A3_MIX
#undef A3_STEP
}
}
constexpr int NWAVES = 8;
#ifndef MK_N_LAUNCHES
#define MK_N_LAUNCHES 1
#define REP_PH 7
#define DBGV 2
#endif
constexpr int NPH = 16;
constexpr int T = 16384, D = 1024, SEQ = 8192, DFF = 2816, NIN = 5792;
constexpr size_t MiB = 1u << 20;
constexpr size_t al4k(size_t x) { return (x + 4095) & ~(size_t)4095; }
constexpr size_t WS_CTL = 0, CTL_ZERO_BYTES = 1 * MiB;
constexpr size_t WS_CS = 1 * MiB;
constexpr size_t WS_MISC = 2 * MiB;
constexpr size_t WS_KX = 3 * MiB, WS_VX = WS_KX + 512 * 1024;
constexpr size_t WS_MEMN = 4 * MiB;
constexpr size_t WS_SSQ0 = 5 * MiB, WS_SSQ1 = 6 * MiB, WS_SSQ2 = 7 * MiB, WS_SSQ3 = 8 * MiB;
constexpr size_t WS_SSQL = 9 * MiB;
constexpr size_t WS_WINA = 12 * MiB, WS_WINB = WS_WINA + al4k(768 * 1024 * 2), WS_WQUP = WS_WINB + al4k(5120 * 1024 * 2), WS_WKVUP = WS_WQUP + al4k(768 * 384 * 2),
                 WS_WBRA = WS_WKVUP + al4k(1024 * 256 * 2), WS_WBRB = WS_WBRA + al4k(1024 * 512 * 2), WS_WOUT = WS_WBRB + al4k(1024 * 1024 * 2), WS_WXQ = WS_WOUT + al4k(1024 * 1024 * 2),
                 WS_WXKV = WS_WXQ + al4k(512 * 1024 * 2), WS_WXO = WS_WXKV + al4k(1024 * 1024 * 2), WS_WSMALL_END = WS_WXO + al4k(1024 * 512 * 2);
constexpr size_t WS_WGU = 36 * MiB, WS_WD = WS_WGU + al4k((size_t)5632 * 1024 * 2), WS_WFFN_END = WS_WD + al4k((size_t)1024 * 2816 * 2);
constexpr size_t WS_YA = 36 * MiB;
constexpr size_t WS_HB = 54 * MiB;
constexpr size_t WS_POOL = 86 * MiB;
constexpr size_t WS_HID = WS_POOL;
constexpr size_t WS_LAT = WS_POOL, WS_QM = WS_LAT + 20 * MiB, WS_KM = WS_QM + 24 * MiB, WS_VM = WS_KM + 24 * MiB;
constexpr size_t WS_PB = WS_POOL;
constexpr size_t WS_QX = WS_POOL, WS_OX = WS_QX + 16 * MiB;
constexpr size_t WS_END = WS_PB + 160 * MiB;
static_assert(WS_WSMALL_END <= WS_WGU && WS_WFFN_END <= WS_HB && WS_YA + 16 * MiB <= WS_HB && WS_HB + 32 * MiB <= WS_POOL && WS_VM + 16 * MiB <= WS_END && WS_HID + (size_t)T * DFF * 2 <= WS_END && WS_END <= 256 * MiB, "d_ws map");
constexpr int CW_TMO = 0, CW_CODE = 1, CW_BAR = 4096;

constexpr int RING_OFF = 0, RING_BYTES = 131072;
constexpr int LDSCTL_OFF = 155648, MISC_OFF = LDSCTL_OFF + 320;
constexpr int LDS_BYTES = 163840;
constexpr int ATT_TB_OFF = 77824, ATT_ST_OFF = 79872;
static_assert(att2::core_lds<96, 64>() <= ATT_TB_OFF && att2::core_lds<64, 128>() <= ATT_TB_OFF && att::core_lds<128, 128>() <= LDSCTL_OFF && ATT_ST_OFF + 65536 <= LDSCTL_OFF, "attention LDS");

#define GAS __attribute__((address_space(1)))
#define LAS __attribute__((address_space(3)))
typedef unsigned short bf16;
typedef unsigned v4u __attribute__((ext_vector_type(4)));
typedef float f32x4 __attribute__((ext_vector_type(4)));
typedef short bf16x8 __attribute__((ext_vector_type(8)));
typedef GAS unsigned gu32;
typedef GAS unsigned long long gu64;
#define RLX_AGENT __ATOMIC_RELAXED, __HIP_MEMORY_SCOPE_AGENT
#define LDS_WAIT() asm volatile("s_waitcnt lgkmcnt(0)" ::: "memory")
#define VM_WAIT() asm volatile("s_waitcnt vmcnt(0)" ::: "memory")
__device__ __forceinline__ unsigned long long rt() { return __builtin_amdgcn_s_memrealtime(); }
__device__ __forceinline__ unsigned f2bf(float f) { unsigned u = __builtin_bit_cast(unsigned, f); return (u + 0x7fffu + ((u >> 16) & 1u)) >> 16; }
__device__ __forceinline__ unsigned pk2(float lo, float hi) { return f2bf(lo) | (f2bf(hi) << 16); }

#define XB_TMO      128
#define XB_XCNT(j)  (256  + 64 * (j))
#define XB_XSUB(j)  (1280 + 64 * (j))
#define XB_XGEN(j)  (2304 + 64 * (j))
#define XB_TOP      3328
#define XB_TOPGEN   3392
#define XCD_BAR_WORDS 3456
#define XB_SPIN_CAP (1u << 18)

__device__ __forceinline__ unsigned xb_ld(unsigned* p)              { return __hip_atomic_load(p, __ATOMIC_RELAXED, __HIP_MEMORY_SCOPE_AGENT); }
__device__ __forceinline__ unsigned xb_add(unsigned* p, unsigned v) { return __hip_atomic_fetch_add(p, v, __ATOMIC_RELAXED, __HIP_MEMORY_SCOPE_AGENT); }
__device__ __forceinline__ unsigned xb_xcc_id() { return (unsigned)__builtin_amdgcn_s_getreg((3 << 11) | 20) & 0xFu; }
#define XB_SPIN(cond, bar) do { unsigned _sp = 0; while (cond) { __builtin_amdgcn_s_sleep(1); \
    if ((++_sp & 255u) == 0u) { if (xb_ld(&(bar)[XB_TMO])) break; if (_sp > XB_SPIN_CAP) { atomicAdd(&(bar)[XB_TMO], 1u); break; } } } } while (0)

struct XcdBarrier {
    unsigned* bar; unsigned x;
    volatile LAS unsigned* st;
};

__device__ __forceinline__ XcdBarrier xcd_barrier_post(unsigned* bar, volatile LAS unsigned* st) {
    XcdBarrier b; b.bar = bar; b.x = xb_xcc_id(); b.st = st;
    if (threadIdx.x == 0) (void)xb_add(&bar[XB_XCNT(b.x)], 1u);
    return b;
}
__device__ __forceinline__ void xcd_barrier_complete(unsigned* bar, unsigned x, unsigned& nloc, unsigned& nx) {
    const unsigned G = gridDim.x * gridDim.y * gridDim.z;
    unsigned sum, cnt, mine, sp = 0u;
    for (;;) {
        sum = 0u; cnt = 0u; mine = 0u;
#pragma unroll
        for (unsigned j = 0; j < 16; ++j) { const unsigned c = xb_ld(&bar[XB_XCNT(j)]); sum += c; cnt += (c > 0u) ? 1u : 0u; mine = (j == x) ? c : mine; }
        if (sum == G) break;
        __builtin_amdgcn_s_sleep(1);
        if ((++sp & 255u) == 0u) { if (xb_ld(&bar[XB_TMO])) break; if (sp > XB_SPIN_CAP) { atomicAdd(&bar[XB_TMO], 1u); break; } }
    }
    nloc = mine > 0u ? mine : 1u; nx = cnt > 0u ? cnt : 1u;
}

__device__ __forceinline__ void xcd_barrier(const XcdBarrier& b) {
    asm volatile("s_waitcnt vmcnt(0)" ::: "memory");
    __syncthreads();
    if (threadIdx.x == 0) {
        unsigned* bar = b.bar;
        __builtin_amdgcn_s_waitcnt(0);
        unsigned nloc = b.st[0], nx = b.st[1];
        if (nloc == 0u) { xcd_barrier_complete(bar, b.x, nloc, nx); b.st[0] = nloc; b.st[1] = nx; }
        const unsigned old = xb_add(&bar[XB_XSUB(b.x)], 1u);
        const unsigned gen = old / nloc;
        if (old + 1u == (gen + 1u) * nloc) {
            __builtin_amdgcn_fence(__ATOMIC_RELEASE, "agent");
            asm volatile("s_waitcnt vmcnt(0)" ::: "memory");
            const unsigned og = xb_add(&bar[XB_TOP], 1u);
            const unsigned tg = og / nx;
            if (og + 1u == (tg + 1u) * nx) xb_add(&bar[XB_TOPGEN], 1u);
            else XB_SPIN(xb_ld(&bar[XB_TOPGEN]) == tg, bar);
            __builtin_amdgcn_fence(__ATOMIC_ACQUIRE, "agent");
            xb_add(&bar[XB_XGEN(b.x)], 1u);
            asm volatile("s_waitcnt vmcnt(0)" ::: "memory");
        } else {
            XB_SPIN(xb_ld(&bar[XB_XGEN(b.x)]) == gen, bar);
            __builtin_amdgcn_fence(__ATOMIC_ACQUIRE, "agent");
            asm volatile("s_waitcnt vmcnt(0)" ::: "memory");
        }
    }
    __syncthreads();
}

struct Frame {
    LAS unsigned char* lds;
    volatile LAS unsigned* MISC;
    gu32* ctl;
    int tid, lane, wave;
    int vcu, G;
};
__device__ __forceinline__ float wave_sum(float v) {
#pragma unroll
    for (int o = 1; o < 64; o <<= 1) v += __shfl_xor(v, o);
    return v;
}
__device__ __forceinline__ void wt_item(const float* W, int Nsrc, int ncol0, const float* gain, bf16* WT, int K, int k0, int drow0, bool rope, LAS float* scr, int lane) {
#pragma unroll 8
    for (int i = 0; i < 32; ++i) { const int kk = 2 * i + (lane >> 5); float v = 0.f;
        if (ncol0 >= 0) { v = W[(size_t)(k0 + kk) * Nsrc + ncol0 + (lane & 31)]; if (gain) v *= gain[k0 + kk]; }
        scr[kk * 33 + (lane & 31)] = v; }
    LDS_WAIT(); asm volatile("" ::: "memory");
    const int c = lane & 7;
#pragma unroll
    for (int j = 0; j < 4; ++j) { const int n = (lane >> 3) + 8 * j; const int ns = rope ? (16 * ((n >> 2) & 1) + 4 * (n >> 3) + (n & 3)) : n; const LAS float* s = scr + (8 * c) * 33 + ns;
        v4u o; o.x = pk2(s[0 * 33], s[1 * 33]); o.y = pk2(s[2 * 33], s[3 * 33]); o.z = pk2(s[4 * 33], s[5 * 33]); o.w = pk2(s[6 * 33], s[7 * 33]);
        *(GAS v4u*)(WT + (size_t)(drow0 + n) * K + k0 + 8 * c) = o; }
    LDS_WAIT(); asm volatile("" ::: "memory");
}
__device__ __forceinline__ void wt_job_item(const float* W, const float* W2, const float* gain, bf16* WT, int K, int Nsrc, int nblk, int mode, int item, LAS float* scr, int lane) {
    const int kb = item / nblk, b = item % nblk; const float* src = W; int ncol0 = 32 * b; bool rope = false;
    if (mode == 1) { const int tile = b >> 3, w = b & 7; if (w < 4) ncol0 = 128 * tile + 32 * w; else { src = W2; ncol0 = 128 * tile + 32 * (w - 4); } }
    else if (mode == 2) { if (b >= 21) ncol0 = -1; rope = (b == 20); }
    else if (mode == 3) ncol0 = 672 + 32 * b;
    else if (mode == 4) rope = (b % 3) == 2;
    else if (mode == 5) { if (b < 16) ncol0 = (b >> 1) * 128 + 32 * (b & 1); else { const int b2 = b - 16; ncol0 = (b2 >> 1) * 128 + 64 + 32 * (b2 & 1); } }
    else if (mode == 6) { if (b < 16) ncol0 = (b >> 2) * 256 + 32 * (b & 3); else { const int b2 = b - 16; ncol0 = (b2 >> 2) * 256 + 128 + 32 * (b2 & 3); } }
    wt_item(src, Nsrc, ncol0, gain, WT, K, 64 * kb, 32 * b, rope, scr, lane);
}
#define WJOB(Wp, W2p, gainp, dst, K_, Ns_, nb_, mode_) { const int items_ = ((K_) / 64) * (nb_); if (r < items_) { wt_job_item((Wp), (W2p), (gainp), (dst), (K_), (Ns_), (nb_), (mode_), r, scr, plane); continue; } r -= items_; }
__device__ __forceinline__ int t5_bucket(int rel) {
    const int n = rel < 0 ? -rel : rel; int v;
    if (n < 8) v = n; else if (n < 12) v = 8; else if (n < 16) v = 9; else if (n < 23) v = 10; else if (n < 32) v = 11; else if (n < 46) v = 12; else if (n < 64) v = 13; else if (n < 91) v = 14; else v = 15;
    return (rel > 0 ? 16 : 0) + v;
}

#ifndef ATTNS
#define ATTNS att3
#endif
#ifndef DBGV
#define DBGV 0
#endif
#ifndef PH_MASK
#define PH_MASK 0xffff
#endif
#define PHEN(k) (((PH_MASK) >> (k)) & 1)
struct Args { const float* in[31]; float* out; unsigned char* ws; int ph_lo, ph_hi, li, pad; };
#define HB ((bf16*)(args.ws + WS_HB))
#define HID ((bf16*)(args.ws + WS_HID))
#define LAT ((bf16*)(args.ws + WS_LAT))
#define QM ((bf16*)(args.ws + WS_QM))
#define KM ((bf16*)(args.ws + WS_KM))
#define VM ((bf16*)(args.ws + WS_VM))
#define PB ((bf16*)(args.ws + WS_PB))
#define YA ((bf16*)(args.ws + WS_YA))
#define QX ((bf16*)(args.ws + WS_QX))
#define OX ((bf16*)(args.ws + WS_OX))
#define KX ((bf16*)(args.ws + WS_KX))
#define VX ((bf16*)(args.ws + WS_VX))
#define MEMN ((bf16*)(args.ws + WS_MEMN))
#define WINA ((bf16*)(args.ws + WS_WINA))
#define WINB ((bf16*)(args.ws + WS_WINB))
#define WQUP ((bf16*)(args.ws + WS_WQUP))
#define WKVUP ((bf16*)(args.ws + WS_WKVUP))
#define WBRA ((bf16*)(args.ws + WS_WBRA))
#define WBRB ((bf16*)(args.ws + WS_WBRB))
#define WOUT ((bf16*)(args.ws + WS_WOUT))
#define WXQ ((bf16*)(args.ws + WS_WXQ))
#define WXKV ((bf16*)(args.ws + WS_WXKV))
#define WXO ((bf16*)(args.ws + WS_WXO))
#define WGU ((bf16*)(args.ws + WS_WGU))
#define WD ((bf16*)(args.ws + WS_WD))
#define CS ((float*)(args.ws + WS_CS))
#define TB ((float*)(args.ws + WS_MISC))
#define LAM ((float*)(args.ws + (WS_MISC + 8192)))
#define SSQ0 ((float*)(args.ws + WS_SSQ0))
#define SSQ1 ((float*)(args.ws + WS_SSQ1))
#define SSQ2 ((float*)(args.ws + WS_SSQ2))
#define SSQ3 ((float*)(args.ws + WS_SSQ3))
#define SSQL ((float*)(args.ws + WS_SSQL))
template <int ph> __device__ __forceinline__ void run_phase(const Args& args, Frame& F, const bool dry = false) {
    const float* x = args.in[0]; float* out = args.out;
        int ptid = threadIdx.x; asm volatile("" : "+v"(ptid)); const int plane = ptid & 63;
        if (PHEN(0) && ph == 0) {
            LAS float* scr = (LAS float*)(F.lds + RING_OFF + F.wave * 16384);
            const int gw = F.vcu * NWAVES + F.wave, NGW = F.G * NWAVES;
            constexpr int NITEMS = 16 * 176 + 44 * 32 + 16 * 24 + 16 * 160 + 6 * 24 + 4 * 32 + 8 * 32 + 16 * 32 + 16 * 32 + 16 * 16 + 16 * 32 + 8 * 32;
            for (int it = gw; it < NITEMS; it += NGW) {
                int r = it;
                WJOB(args.in[3], args.in[4], args.in[2], WGU, 1024, 2816, 176, 1)
                WJOB(args.in[5], nullptr, nullptr, WD, 2816, 1024, 32, 0)
                WJOB(args.in[7], nullptr, args.in[6], WINA, 1024, NIN, 24, 2)
                WJOB(args.in[7], nullptr, args.in[6], WINB, 1024, NIN, 160, 3)
                WJOB(args.in[9], nullptr, args.in[8], WQUP, 384, 768, 24, 4)
                WJOB(args.in[11], nullptr, args.in[10], WKVUP, 256, 1024, 32, 5)
                WJOB(args.in[18], nullptr, nullptr, WBRA, 512, 1024, 32, 0)
                WJOB(args.in[19], nullptr, nullptr, WBRB, 1024, 1024, 32, 0)
                WJOB(args.in[20], nullptr, nullptr, WOUT, 1024, 1024, 32, 0)
                WJOB(args.in[23], nullptr, args.in[21], WXQ, 1024, 512, 16, 0)
                WJOB(args.in[24], nullptr, nullptr, WXKV, 1024, 1024, 32, 6)
                WJOB(args.in[25], nullptr, nullptr, WXO, 512, 1024, 32, 0)
            }
            for (int m = gw; m < T; m += NGW) {
                const GAS f32x4* xr = (const GAS f32x4*)(x + (size_t)m * D) + plane; f32x4 v[4]; float s = 0.f;
#pragma unroll
                for (int j = 0; j < 4; ++j) { v[j] = xr[64 * j]; s += (v[j].x * v[j].x + v[j].y * v[j].y) + (v[j].z * v[j].z + v[j].w * v[j].w); }
                s = wave_sum(s);
                GAS unsigned long long* o8 = (GAS unsigned long long*)(HB + (size_t)m * D) + plane;
#pragma unroll
                for (int j = 0; j < 4; ++j) o8[64 * j] = (unsigned long long)pk2(v[j].x, v[j].y) | ((unsigned long long)pk2(v[j].z, v[j].w) << 32);
                if (plane < 16) SSQ0[(size_t)m * 16 + plane] = plane == 0 ? s : 0.f;
            }
            for (int m = gw; m < 512; m += NGW) {
                const GAS f32x4* xr = (const GAS f32x4*)(args.in[1] + (size_t)m * D) + plane; const GAS f32x4* gr = (const GAS f32x4*)(args.in[22]) + plane; f32x4 v[4]; float s = 0.f;
#pragma unroll
                for (int j = 0; j < 4; ++j) { v[j] = xr[64 * j]; s += (v[j].x * v[j].x + v[j].y * v[j].y) + (v[j].z * v[j].z + v[j].w * v[j].w); }
                const float rstd = 1.0f / sqrtf(wave_sum(s) * (1.0f / D) + 1e-6f);
                GAS unsigned long long* o8 = (GAS unsigned long long*)(MEMN + (size_t)m * D) + plane;
#pragma unroll
                for (int j = 0; j < 4; ++j) { const f32x4 g = gr[64 * j]; o8[64 * j] = (unsigned long long)pk2(v[j].x * rstd * g.x, v[j].y * rstd * g.y) | ((unsigned long long)pk2(v[j].z * rstd * g.z, v[j].w * rstd * g.w) << 32); }
            }
            for (int e = (F.vcu * NWAVES * 64) + ptid; e < SEQ * 16; e += F.G * NWAVES * 64) { const int pos = e >> 4, i = e & 15;
                const float freq = powf(10000.0f, -(float)i / 16.0f); const float ang = (float)pos * freq;
                CS[(size_t)pos * 32 + i] = cosf(ang); CS[(size_t)pos * 32 + 16 + i] = sinf(ang); }
            if (blockIdx.x == 0) {
                const float* rb = args.in[17];
                for (int e = ptid; e < 8 * 256; e += NWAVES * 64) { const int h = e >> 8, idx = e & 255; const int rel = idx - 128;
                    TB[e] = (rb[t5_bucket(rel) * 8 + h] - rb[15 * 8 + h]) * 1.4426950408889634f; }
                if (F.wave == 0) { const float a = args.in[12][plane] * args.in[13][plane], b2 = args.in[14][plane] * args.in[15][plane];
                    const float sa = wave_sum(a), sb = wave_sum(b2); if (plane == 0) LAM[0] = expf(sa) - expf(sb) + 0.2f; }
            }
        }
        else if (PHEN(1) && (ph == 1 || ph == 13)) {
            pg8::Gemm g{HB, WGU, T, 5632, 1024, 1024}; pg8::StaticOrder S; S.init(T, 5632, F.G, (int)blockIdx.x);
            pg8::EpiGateUp E{HID, DFF, ph == 1 ? SSQ0 : SSQ3};
            pg8::gemm_phase<pg8::EpiGateUp, pg8::StaticOrder, true, true>(F.lds + RING_OFF, g, S, E);
        }
        else if (PHEN(2) && (ph == 2 || ph == 9 || ph == 12 || ph == 14)) {
            pg8::Gemm g; pg8::EpiRes E;
            if (ph == 2)       { g = pg8::Gemm{HID, WD, T, 1024, DFF, DFF};          E = pg8::EpiRes{x, out, HB, SSQ1, 0.5f}; }
            else if (ph == 9)  { g = pg8::Gemm{PB + 3072, WOUT, T, 1024, 1024, 5120}; E = pg8::EpiRes{out, out, HB, SSQ2, 1.0f}; }
            else if (ph == 12) { g = pg8::Gemm{OX, WXO, T, 1024, 512, 512};          E = pg8::EpiRes{out, out, HB, SSQ3, 1.0f}; }
            else               { g = pg8::Gemm{HID, WD, T, 1024, DFF, DFF};          E = pg8::EpiRes{out, out, nullptr, nullptr, 0.5f}; }
            pg8::StaticOrder S; S.init(T, 1024, F.G, (int)blockIdx.x);
            pg8::gemm_phase<pg8::EpiRes, pg8::StaticOrder, true, true>(F.lds + RING_OFF, g, S, E);
        }
        else if (PHEN(3) && ph == 3) {
            pg8::Gemm g{HB, WINA, T, 768, 1024, 1024}; pg8::StaticOrder S; S.init(T, 768, F.G, (int)blockIdx.x);
            pg8::EpiLat E{LAT, SSQL, KM, CS, SSQ1};
            pg8::gemm_phase<pg8::EpiLat, pg8::StaticOrder, true, true>(F.lds + RING_OFF, g, S, E);
        }
        else if (PHEN(4) && ph == 4) {
#ifndef P4_SKIP_A
            { pg8::Gemm g{LAT, WQUP, T, 768, 384, 640}; pg8::StaticOrder S; S.init(T, 768, F.G, (int)blockIdx.x); pg8::EpiQup E{QM, SSQL, CS, 0.10206207261596575f * 1.4426950408889634f};
              pg8::gemm_phase<pg8::EpiQup, pg8::StaticOrder, true, true>(F.lds + RING_OFF, g, S, E); }
#endif
#ifndef P4_SKIP_B
            { pg8::Gemm g{LAT + 384, WKVUP, T, 1024, 256, 640}; pg8::StaticOrder S; S.init(T, 1024, F.G, (int)blockIdx.x); pg8::EpiKVup E{KM, VM, SSQL};
              pg8::gemm_phase<pg8::EpiKVup, pg8::StaticOrder, true, true>(F.lds + RING_OFF, g, S, E); }
#endif
        }
        else if (PHEN(5) && ph == 5) {
            const int bh = F.vcu >> 4, s = F.vcu & 15, b = bh >> 3, h = bh & 7;
            if (F.vcu < 256) for (int i = 0; i < 2; ++i) { const int qb = i ? s : 31 - s; const long rowbase = (long)b * SEQ; const int q0 = qb * 256;
                att::f32x16 o[2];
                ATTNS::attn_core<96, 64, 768, 768, 512, true, false>(QM + (rowbase + q0) * 768 + h * 96, KM + rowbase * 768 + h * 96, VM + rowbase * 512 + h * 64, 4 * (qb + 1),
                    1.0f, 8.0f, nullptr, q0, (att::lptr)(F.lds + RING_OFF), o, dry ? DBGV : 0);
                int l1 = plane; asm volatile("" : "+v"(l1)); const int r32 = l1 & 31, hi2 = l1 >> 5;
                bf16* Ow = YA + (rowbase + q0 + F.wave * 32) * 512 + h * 64;
#pragma unroll
                for (int r = 0; r < 16; ++r) { const int orow = att::crow(r, hi2);
#pragma unroll
                    for (int d0 = 0; d0 < 2; ++d0) Ow[(long)orow * 512 + d0 * 32 + r32] = (bf16)f2bf(o[d0][r]); } }
        }
        else if (PHEN(6) && (ph == 6 || ph == 10)) {
            if (ph == 6) { pg8::Gemm g{HB, WINB, T, 5120, 1024, 1024}; pg8::StaticOrder S; S.init(T, 5120, F.G, (int)blockIdx.x); pg8::EpiProj E{PB, 5120, SSQ1, 12, nullptr, 1 << 30, 0.125f * 1.4426950408889634f, 4};
                pg8::gemm_phase<pg8::EpiProj, pg8::StaticOrder, true, true>(F.lds + RING_OFF, g, S, E); }
            else {
                const int bx = (int)blockIdx.x; pg8::Gemm g; pg8::StaticOrder S; pg8::EpiProj E;
                if (bx < 128) { g = pg8::Gemm{HB, WXQ, T, 512, 1024, 1024}; S.init(T, 512, F.G, bx); E = pg8::EpiProj{QX, 512, SSQ2, 1 << 30, nullptr, 1 << 30, 1.0f, 0}; }
                else { g = pg8::Gemm{MEMN, WXKV, 512, 1024, 1024, 1024}; S.init(512, 1024, F.G, bx < 136 ? bx - 128 : -1); E = pg8::EpiProj{KX, 512, nullptr, 1 << 30, VX, 512, 1.0f, 0}; }
                pg8::gemm_phase<pg8::EpiProj, pg8::StaticOrder, true, true>(F.lds + RING_OFF, g, S, E);
                if (bx >= 136) {
                    LAS float* scr = (LAS float*)(F.lds + RING_OFF + F.wave * 16384);
                    const int gw = (bx - 136) * NWAVES + F.wave, NGW = (F.G - 136) * NWAVES;
                    for (int it = gw; it < 16 * 176 + 44 * 32; it += NGW) { int r = it;
                        WJOB(args.in[27], args.in[28], args.in[26], WGU, 1024, 2816, 176, 1)
                        WJOB(args.in[29], nullptr, nullptr, WD, 2816, 1024, 32, 0) }
                }
            }
        }
        else if (PHEN(7) && ph == 7) {
            const int bh = F.vcu >> 4, s = F.vcu & 15, b = bh >> 3, h = bh & 7;
            LAS float* tb = (LAS float*)(F.lds + ATT_TB_OFF);
            if (ptid < 256) tb[ptid] = TB[h * 256 + ptid];
            if (F.vcu < 256) for (int i = 0; i < 2; ++i) { const int qb = i ? s : 31 - s; const long rowbase = (long)b * SEQ; const int q0 = qb * 256;
                att::f32x16 o[4];
#pragma unroll 1
                for (int map = 0; map < 2; ++map) {
                    ATTNS::attn_core<64, 128, 5120, 5120, 5120, true, true>(PB + (rowbase + q0) * 5120 + h * 128 + map * 64, PB + rowbase * 5120 + 1024 + h * 128 + map * 64, PB + rowbase * 5120 + 2048 + h * 128,
                        4 * (qb + 1), 1.0f, 8.0f, (const LAS float*)tb, q0, (att::lptr)(F.lds + RING_OFF), o, dry ? DBGV : 0);
                    if (map == 0) { int l0 = plane; asm volatile("" : "+v"(l0)); LAS unsigned* st = (LAS unsigned*)(F.lds + ATT_ST_OFF) + F.wave * (32 * 64) + l0;
#pragma unroll
                        for (int d0 = 0; d0 < 4; ++d0)
#pragma unroll
                            for (int r = 0; r < 16; r += 2) st[(d0 * 8 + (r >> 1)) * 64] = pg8::cvt_pk_bf16(o[d0][r], o[d0][r + 1]);
                    }
                }
                int l1 = plane; asm volatile("" : "+v"(l1)); const int r32 = l1 & 31, hi2 = l1 >> 5;
                LAS unsigned* st = (LAS unsigned*)(F.lds + ATT_ST_OFF) + F.wave * (32 * 64) + l1;
                const float lam = LAM[0]; float gsn[4];
#pragma unroll
                for (int d0 = 0; d0 < 4; ++d0) gsn[d0] = args.in[16][d0 * 32 + r32] * 0.8f;
                bf16* Ow = (dry ? (bf16*)(args.ws + 246 * MiB) : PB + (rowbase + q0) * 5120) + F.wave * 32 * 5120 + h * 128;
#pragma unroll
                for (int r = 0; r < 16; r += 2) { float q0s = 0.f, q1s = 0.f; float c0[4], c1[4];
#pragma unroll
                    for (int d0 = 0; d0 < 4; ++d0) { const unsigned w = st[(d0 * 8 + (r >> 1)) * 64]; c0[d0] = pg8::bf_lo(w) - lam * o[d0][r]; c1[d0] = pg8::bf_hi(w) - lam * o[d0][r + 1]; q0s += c0[d0] * c0[d0]; q1s += c1[d0] * c1[d0]; }
#pragma unroll
                    for (int sh = 1; sh < 32; sh <<= 1) { q0s += __shfl_xor(q0s, sh); q1s += __shfl_xor(q1s, sh); }
                    const float n0 = 1.0f / sqrtf(q0s * (1.0f / 128.0f) + 1e-6f), n1 = 1.0f / sqrtf(q1s * (1.0f / 128.0f) + 1e-6f);
                    const int or0 = att::crow(r, hi2), or1 = att::crow(r + 1, hi2);
#pragma unroll
                    for (int d0 = 0; d0 < 4; ++d0) { Ow[(long)or0 * 5120 + d0 * 32 + r32] = (bf16)f2bf(c0[d0] * n0 * gsn[d0]); Ow[(long)or1 * 5120 + d0 * 32 + r32] = (bf16)f2bf(c1[d0] * n1 * gsn[d0]); } }
                LDS_WAIT(); }
        }
        else if (PHEN(8) && ph == 8) {
            { pg8::Gemm g{YA, WBRA, T, 1024, 512, 512}; pg8::StaticOrder S; S.init(T, 1024, F.G, (int)blockIdx.x); pg8::EpiBranch<0> E{PB};
              pg8::gemm_phase<pg8::EpiBranch<0>, pg8::StaticOrder, true, true>(F.lds + RING_OFF, g, S, E); }
            { pg8::Gemm g{PB, WBRB, T, 1024, 1024, 5120}; pg8::StaticOrder S; S.init(T, 1024, F.G, (int)blockIdx.x); pg8::EpiBranch<1> E{PB};
              pg8::gemm_phase<pg8::EpiBranch<1>, pg8::StaticOrder, true, true>(F.lds + RING_OFF, g, S, E); }
        }
        else if (PHEN(11) && ph == 11) {
            const int tile = F.vcu >> 2, hh = F.vcu & 3, b = tile >> 5; const int lane = plane; const int r32 = lane & 31, hi2 = lane >> 5;
            if (F.vcu < 256) { att::f32x16 o[4];
                att::attn_core<128, 128, 512, 512, 512, false, false, 1>(QX + (long)tile * 256 * 512 + hh * 128, KX + (long)b * 256 * 512 + hh * 128, VX + (long)b * 256 * 512 + hh * 128, 4,
                    0.08838834764831845f * 1.4426950408889634f, 8.0f / 0.08838834764831845f, nullptr, 0, (att::lptr)(F.lds + RING_OFF), o);
                bf16* Ow = OX + ((long)tile * 256 + F.wave * 32) * 512 + hh * 128;
#pragma unroll
                for (int r = 0; r < 16; ++r) { const int orow = att::crow(r, hi2);
#pragma unroll
                    for (int d0 = 0; d0 < 4; ++d0) Ow[(long)orow * 512 + d0 * 32 + r32] = (bf16)f2bf(o[d0][r]); } }
        }
        else if (PHEN(15) && ph == 15) {
            const int gw = F.vcu * NWAVES + F.wave, NGW = F.G * NWAVES; const GAS f32x4* gr = (const GAS f32x4*)(args.in[30]) + plane;
            for (int m = gw; m < T; m += NGW) { GAS f32x4* xr = (GAS f32x4*)(out + (size_t)m * D) + plane; f32x4 v[4]; float s = 0.f;
#pragma unroll
                for (int j = 0; j < 4; ++j) { v[j] = xr[64 * j]; s += (v[j].x * v[j].x + v[j].y * v[j].y) + (v[j].z * v[j].z + v[j].w * v[j].w); }
                const float rstd = 1.0f / sqrtf(wave_sum(s) * (1.0f / D) + 1e-6f);
#pragma unroll
                for (int j = 0; j < 4; ++j) xr[64 * j] = v[j] * rstd * gr[64 * j]; }
        }
}
__global__ void __launch_bounds__(NWAVES * 64, 2) mega_fwd(Args args) {
    extern __shared__ __attribute__((aligned(16))) unsigned char lds[];
    Frame F;
    F.lds = (LAS unsigned char*)lds;
    F.MISC = (volatile LAS unsigned*)(F.lds + MISC_OFF);
    F.tid = threadIdx.x; F.lane = F.tid & 63; F.wave = __builtin_amdgcn_readfirstlane(F.tid >> 6);
    F.G = gridDim.x; { const int bx = blockIdx.x; F.vcu = (F.G % 8 == 0) ? (bx % 8) * (F.G / 8) + bx / 8 : bx; }
    F.ctl = (gu32*)(args.ws + WS_CTL);
    for (int u = F.tid; u < (LDS_BYTES - LDSCTL_OFF) / 4; u += NWAVES * 64) ((LAS unsigned*)(F.lds + LDSCTL_OFF))[u] = 0u;
    __syncthreads();
    XcdBarrier bar; bar.bar = (unsigned*)(F.ctl + CW_BAR) + args.li * XCD_BAR_WORDS; bar.x = 0; bar.st = nullptr;
    const int lo = args.ph_lo, hi = args.ph_hi;
    if (hi - lo > 1) bar = xcd_barrier_post((unsigned*)(F.ctl + CW_BAR) + args.li * XCD_BAR_WORDS, F.MISC + 8);
#ifdef STAMP_PH
    unsigned long long* const ts_ = (unsigned long long*)(args.ws + WS_MISC + 16384); const bool stamper_ = (blockIdx.x == 0 && threadIdx.x == 0);
    if (stamper_) ts_[0] = rt();
#define RUN_PH(k) if (lo <= (k) && (k) < hi) { run_phase<(k)>(args, F); xcd_barrier(bar); if (stamper_) ts_[(k) + 1] = rt(); }
#else
#ifdef REP_PH
#define RUN_PH(k) if (lo <= (k) && (k) < hi) { if ((k) == REP_PH) { _Pragma("unroll 1") for (int rep_ = args.pad; rep_ > 0; --rep_) { run_phase<(k)>(args, F, rep_ > 1); xcd_barrier(bar); } } else { run_phase<(k)>(args, F); if ((k) + 1 < hi) xcd_barrier(bar); } }
#else
#define RUN_PH(k) if (lo <= (k) && (k) < hi) { run_phase<(k)>(args, F); if ((k) + 1 < hi) xcd_barrier(bar); }
#endif
#endif
    RUN_PH(0) RUN_PH(1) RUN_PH(2) RUN_PH(3) RUN_PH(4) RUN_PH(5) RUN_PH(6) RUN_PH(7) RUN_PH(8) RUN_PH(9) RUN_PH(10) RUN_PH(11) RUN_PH(12) RUN_PH(13) RUN_PH(14) RUN_PH(15)
#undef RUN_PH
#ifdef XBAR
    _Pragma("unroll 1") for (int xb_ = 0; xb_ < XBAR; ++xb_) xcd_barrier(bar);
#endif
#ifdef STAMP_PH
    xcd_barrier(bar);
    { const float cst = sqrtf((float)(ts_[STAMP_PH + 1] - ts_[STAMP_PH]) * 0.01f);
      for (size_t i = (size_t)blockIdx.x * 512 + threadIdx.x; i < (size_t)T * D; i += (size_t)gridDim.x * 512) args.out[i] = cst; }
#endif
}

extern "C" void kernel_launch(void* const* d_in, const int* in_sizes, int n_in, void* d_out, int out_size, void* d_ws, size_t ws_size, hipStream_t stream) {
    static int grid = 0;
    if (grid == 0) {
        if (n_in != 31 || in_sizes[0] != T * D || out_size != T * D || ws_size < WS_END) { fprintf(stderr, "kernel_launch: unexpected shapes (n_in %d, in0 %d, out %d, ws %zu)\n", n_in, n_in > 0 ? in_sizes[0] : -1, out_size, ws_size); grid = -1; return; }
        int dev = 0, cus = 0, per_cu = 0;
        if (hipGetDevice(&dev) != hipSuccess || hipDeviceGetAttribute(&cus, hipDeviceAttributeMultiprocessorCount, dev) != hipSuccess) { grid = -1; return; }
        if (hipFuncSetAttribute((const void*)mega_fwd, hipFuncAttributeMaxDynamicSharedMemorySize, LDS_BYTES) != hipSuccess) { fprintf(stderr, "kernel_launch: hipFuncSetAttribute failed\n"); grid = -1; return; }
        if (hipOccupancyMaxActiveBlocksPerMultiprocessor(&per_cu, (const void*)mega_fwd, NWAVES * 64, LDS_BYTES) != hipSuccess || per_cu < 1) fprintf(stderr, "kernel_launch: occupancy query says %d\n", per_cu);
        (void)hipGetLastError();
        grid = cus;
        if (grid != 256) fprintf(stderr, "kernel_launch: %d CUs (expected 256)\n", grid);
    }
    if (grid < 0) return;
    if (hipMemsetAsync((char*)d_ws + WS_CTL, 0, CTL_ZERO_BYTES, stream) != hipSuccess) return;
    Args a{};
    for (int i = 0; i < 31; ++i) a.in[i] = (const float*)d_in[i];
    a.out = (float*)d_out; a.ws = (unsigned char*)d_ws;
#ifdef REP_PH
    a.pad = 2;
#endif
    const int nl = MK_N_LAUNCHES;
    for (int li = 0; li < nl; ++li) {
        a.ph_lo = (nl == 1) ? 0 : li; a.ph_hi = (nl == 1) ? NPH : li + 1; a.li = 0;
        hipLaunchKernelGGL(mega_fwd, dim3(grid), dim3(NWAVES * 64), LDS_BYTES, stream, a);
        const hipError_t le = hipPeekAtLastError();
        if (le != hipSuccess) { fprintf(stderr, "kernel_launch: launch %d failed: %s\n", li, hipGetErrorName(le)); break; }
    }
}
```

```cpp
#include <hip/hip_runtime.h>
#include <cstdio>
#include <cstdint>
#include <cmath>
namespace pg8 {
#define PG8_LAS __attribute__((address_space(3)))
typedef unsigned short bf16_t;
typedef short bf16x8 __attribute__((ext_vector_type(8)));
typedef float f32x4 __attribute__((ext_vector_type(4)));
typedef unsigned u32x4 __attribute__((ext_vector_type(4)));
typedef unsigned u32x2 __attribute__((ext_vector_type(2)));
constexpr int BM = 256, BK = 64, HALF = 128, HTB = HALF * BK * 2  , STAGE_BYTES = 8 * HTB, NXCD = 8, WGM = 8;

__host__ __device__ __forceinline__ int lds_byte(int r, int c) { const int st = (r >> 4) * 2 + (c >> 5), rr = r & 15, cc = c & 31, ob = rr * 64 + cc * 2; return st * 1024 + (ob ^ (((ob >> 9) & 1) << 5)); }
__host__ __device__ __forceinline__ void stage_rc(int b, int& R, int& C) { const int st = b / 1024, sb = b % 1024, swz = sb ^ (((sb >> 9) & 1) << 5); R = (st >> 1) * 16 + swz / 64; C = (st & 1) * 32 + (swz % 64) / 2; }
__host__ __device__ __forceinline__ int perm32(int rho) { const int n = rho >> 4, i = rho & 15; return 8 * (i >> 2) + 4 * n + (i & 3); }

struct Unit { int pm, pn; };
struct Gemm { const bf16_t* A; const bf16_t* Bt; int M, N, K, lda; };

struct StaticOrder {
    int nM, nN, nwg, G, c;
    __host__ __device__ void init(int M, int N, int G_, int c_) { nM = M / BM; nN = N / BM; nwg = nM * nN; G = G_; c = c_; }
    __host__ __device__ bool next(int i, Unit& u) const {
        if (c < 0) return false;
        const long L = (long)i * G + c; if (L >= nwg) return false;
        int wgid = (int)L; { const int q = nwg / NXCD, r = nwg % NXCD, xcd = wgid % NXCD, off = wgid / NXCD; wgid = (xcd < r ? xcd * (q + 1) : r * (q + 1) + (xcd - r) * q) + off; }
        const int nig = WGM * nN, gid = wgid / nig, fm = gid * WGM, gsz = (nM - fm) < WGM ? (nM - fm) : WGM;
        u.pm = fm + ((wgid % nig) % gsz); u.pn = (wgid % nig) / gsz; return true;
    }
    __device__ __forceinline__ void a_ready(const Unit&) const {}
    __device__ __forceinline__ void done(const Unit&) const {}
};

typedef float f32x2 __attribute__((ext_vector_type(2))); typedef __bf16 bf16x2_t __attribute__((ext_vector_type(2)));
__device__ __forceinline__ unsigned cvt_pk_bf16(float lo, float hi) { f32x2 v = {lo, hi}; bf16x2_t b = __builtin_convertvector(v, bf16x2_t); return __builtin_bit_cast(unsigned, b); }
__device__ __forceinline__ u32x4 pack8(f32x4 a, f32x4 b) { u32x4 w; w.x = cvt_pk_bf16(a[0], a[1]); w.y = cvt_pk_bf16(a[2], a[3]); w.z = cvt_pk_bf16(b[0], b[1]); w.w = cvt_pk_bf16(b[2], b[3]); return w; }
__device__ __forceinline__ u32x2 pack4(f32x4 a) { u32x2 w; w.x = cvt_pk_bf16(a[0], a[1]); w.y = cvt_pk_bf16(a[2], a[3]); return w; }
__device__ __forceinline__ float bf_lo(unsigned w) { return __uint_as_float(w << 16); }
__device__ __forceinline__ float bf_hi(unsigned w) { return __uint_as_float(w & 0xffff0000u); }
constexpr float RMS_EPS = 1e-6f;
template <int NV4> __device__ __forceinline__ float parts_sum(const float* p, int fq) {
    const f32x4 v = *(const f32x4*)(p + 4 * (fq < NV4 ? fq : NV4 - 1)); float s = (v[0] + v[1]) + (v[2] + v[3]);
    if (NV4 < 4) s = fq < NV4 ? s : 0.f;
    s += __shfl_xor(s, 16); s += __shfl_xor(s, 32);
    return s;
}
template <int NV4> __device__ __forceinline__ void unit_rstd(float (&rs)[2][4], const float* parts, int pitch, int row0, int fq, float inv_dim) {
#pragma unroll
    for (int ai = 0; ai < 2; ++ai)
#pragma unroll
        for (int m = 0; m < 4; ++m) rs[ai][m] = 1.0f / sqrtf(parts_sum<NV4>(parts + (size_t)(row0 + ai * HALF + m * 16) * pitch, fq) * inv_dim + RMS_EPS);
}
__device__ __forceinline__ float sigmoidf_(float v) { return __builtin_amdgcn_rcpf(1.0f + __builtin_amdgcn_exp2f(-1.4426950408889634f * v)); }
typedef const f32x4 (&AccRef)[2][2][4][2];

struct EpiGateUp {
    static constexpr bool PERM = true, AFTER_DRAIN = false;
    bf16_t* H; int ldh; const float* ssq;
    __device__ __forceinline__ void operator()(AccRef acc, const Unit& u, int wr, int wc, int fr, int fq) const {
        asm volatile("" : "+v"(fr), "+v"(fq));
        const int row0 = u.pm * BM + wr * 64 + fr, col = u.pn * HALF + wc * 32 + 8 * fq;
        float rs[2][4]; unit_rstd<4>(rs, ssq, 16, row0, fq, 1.0f / 1024.0f);
#pragma unroll
        for (int ai = 0; ai < 2; ++ai)
#pragma unroll
            for (int m = 0; m < 4; ++m) { const float r = rs[ai][m]; f32x4 h[2];
#pragma unroll
                for (int n = 0; n < 2; ++n) { const f32x4 g = acc[ai][0][m][n] * r, up = acc[ai][1][m][n] * r;
#pragma unroll
                    for (int j = 0; j < 4; ++j) h[n][j] = g[j] * up[j] * sigmoidf_(g[j]); }
                *(u32x4*)(H + (size_t)(row0 + ai * HALF + m * 16) * ldh + col) = pack8(h[0], h[1]); asm volatile("" ::: "memory"); }
    }
};
struct EpiRes {
    static constexpr bool PERM = false, AFTER_DRAIN = false;
    const float* base; float* out; bf16_t* hb; float* ssq_out; float alpha;
    __device__ __forceinline__ void operator()(AccRef acc, const Unit& u, int wr, int wc, int fr, int fq) const {
        asm volatile("" : "+v"(fr), "+v"(fq));
        const int row0 = u.pm * BM + wr * 64 + fr, col0 = u.pn * BM + wc * 32 + 4 * fq;
#pragma unroll
        for (int ai = 0; ai < 2; ++ai)
#pragma unroll
            for (int m = 0; m < 4; ++m) { const int row = row0 + ai * HALF + m * 16; const size_t off = (size_t)row * 1024 + col0; float q = 0.f;
#pragma unroll
                for (int bj = 0; bj < 2; ++bj)
#pragma unroll
                    for (int n = 0; n < 2; ++n) { const size_t c = off + bj * HALF + n * 16; const f32x4 o = *(const f32x4*)(base + c) + acc[ai][bj][m][n] * alpha;
                        *(f32x4*)(out + c) = o; q += (o[0] * o[0] + o[1] * o[1]) + (o[2] * o[2] + o[3] * o[3]);
                        if (hb) *(u32x2*)(hb + c) = pack4(o); }
                q += __shfl_xor(q, 16); q += __shfl_xor(q, 32);
                if (ssq_out && fq == 0) ssq_out[(size_t)row * 16 + u.pn * 4 + wc] = q;
                if (m & 1) asm volatile("" ::: "memory"); }
    }
};
struct EpiLat {
    static constexpr bool PERM = true, AFTER_DRAIN = false;
    bf16_t* lat; float* ssql; bf16_t* KM; const float* cs; const float* ssq;
    __device__ __forceinline__ void operator()(AccRef acc, const Unit& u, int wr, int wc, int fr, int fq) const {
        asm volatile("" : "+v"(fr), "+v"(fq));
        const int row0 = u.pm * BM + wr * 64 + fr;
        float rs[2][4]; unit_rstd<4>(rs, ssq, 16, row0, fq, 1.0f / 1024.0f);
#pragma unroll
        for (int bj = 0; bj < 2; ++bj) { const int hh = 2 * u.pn + bj;
            if (hh < 5) {
#pragma unroll
                for (int ai = 0; ai < 2; ++ai)
#pragma unroll
                    for (int m = 0; m < 4; ++m) { const int row = row0 + ai * HALF + m * 16; const float r = rs[ai][m];
                        const f32x4 v0 = acc[ai][bj][m][0] * r, v1 = acc[ai][bj][m][1] * r;
                        float q = (v0[0] * v0[0] + v0[1] * v0[1]) + (v0[2] * v0[2] + v0[3] * v0[3]) + (v1[0] * v1[0] + v1[1] * v1[1]) + (v1[2] * v1[2] + v1[3] * v1[3]);
                        *(u32x4*)(lat + (size_t)row * 640 + hh * HALF + wc * 32 + 8 * fq) = pack8(v0, v1);
                        q += __shfl_xor(q, 16); q += __shfl_xor(q, 32);
                        if (fq == 0) ssql[(size_t)row * 32 + hh * 4 + wc] = q; asm volatile("" ::: "memory"); }
            } else if (wc == 0) {
#pragma unroll
                for (int ai = 0; ai < 2; ++ai)
#pragma unroll
                    for (int m = 0; m < 4; ++m) { const int row = row0 + ai * HALF + m * 16; const float r = rs[ai][m]; const int pos = row & 8191;
                        const f32x4 x1 = acc[ai][bj][m][0] * r, x2 = acc[ai][bj][m][1] * r;
                        const f32x4 co = *(const f32x4*)(cs + (size_t)pos * 32 + 4 * fq), si = *(const f32x4*)(cs + (size_t)pos * 32 + 16 + 4 * fq);
                        const u32x2 o1 = pack4(x1 * co - x2 * si), o2 = pack4(x1 * si + x2 * co);
                        bf16_t* kp = KM + (size_t)row * 768 + 64 + 4 * fq;
#pragma unroll
                        for (int h = 0; h < 8; ++h) { *(u32x2*)(kp + h * 96) = o1; *(u32x2*)(kp + h * 96 + 16) = o2; } asm volatile("" ::: "memory"); }
            }
        }
    }
};
struct EpiQup {
    static constexpr bool PERM = true, AFTER_DRAIN = false;
    bf16_t* QM; const float* ssql; const float* cs; float qscale;
    __device__ __forceinline__ void operator()(AccRef acc, const Unit& u, int wr, int wc, int fr, int fq) const {
        asm volatile("" : "+v"(fr), "+v"(fq));
        const int row0 = u.pm * BM + wr * 64 + fr;
        float rs[2][4]; unit_rstd<3>(rs, ssql, 32, row0, fq, 1.0f / 384.0f);
#pragma unroll
        for (int ai = 0; ai < 2; ++ai)
#pragma unroll
            for (int m = 0; m < 4; ++m) rs[ai][m] *= qscale;
#pragma unroll
        for (int bj = 0; bj < 2; ++bj) { const int s = 8 * u.pn + 4 * bj + wc; bf16_t* qp0 = QM + (size_t)row0 * 768 + 32 * s;
            if ((s % 3) != 2) {
#pragma unroll
                for (int ai = 0; ai < 2; ++ai)
#pragma unroll
                    for (int m = 0; m < 4; ++m) { const float r = rs[ai][m];
                        *(u32x4*)(qp0 + (size_t)(ai * HALF + m * 16) * 768 + 8 * fq) = pack8(acc[ai][bj][m][0] * r, acc[ai][bj][m][1] * r); asm volatile("" ::: "memory"); }
            } else {
                const float* cp0 = cs + (size_t)(row0 & 8191) * 32 + 4 * fq;
#pragma unroll
                for (int ai = 0; ai < 2; ++ai)
#pragma unroll
                    for (int m = 0; m < 4; ++m) { const float r = rs[ai][m]; const f32x4 x1 = acc[ai][bj][m][0] * r, x2 = acc[ai][bj][m][1] * r;
                        const float* cp = cp0 + (size_t)(ai * HALF + m * 16) * 32; const f32x4 co = *(const f32x4*)cp, si = *(const f32x4*)(cp + 16);
                        bf16_t* qp = qp0 + (size_t)(ai * HALF + m * 16) * 768;
                        *(u32x2*)(qp + 4 * fq) = pack4(x1 * co - x2 * si); *(u32x2*)(qp + 16 + 4 * fq) = pack4(x1 * si + x2 * co); asm volatile("" ::: "memory"); }
            }
        }
    }
};
struct EpiKVup {
    static constexpr bool PERM = true, AFTER_DRAIN = false;
    bf16_t* KM; bf16_t* VM; const float* ssql;
    __device__ __forceinline__ void operator()(AccRef acc, const Unit& u, int wr, int wc, int fr, int fq) const {
        asm volatile("" : "+v"(fr), "+v"(fq));
        const int row0 = u.pm * BM + wr * 64 + fr;
        float rs[2][4]; unit_rstd<2>(rs, ssql + 12, 32, row0, fq, 1.0f / 256.0f);
#pragma unroll
        for (int bj = 0; bj < 2; ++bj) { const int cw = u.pn * BM + bj * HALF + wc * 32;
            bf16_t* base; int pitch; if (cw < 512) { base = KM + (cw >> 6) * 96 + (cw & 63); pitch = 768; } else { base = VM + (cw - 512); pitch = 512; }
            base += (size_t)row0 * pitch + 8 * fq;
#pragma unroll
            for (int ai = 0; ai < 2; ++ai)
#pragma unroll
                for (int m = 0; m < 4; ++m) { const float r = rs[ai][m];
                    *(u32x4*)(base + (size_t)(ai * HALF + m * 16) * pitch) = pack8(acc[ai][bj][m][0] * r, acc[ai][bj][m][1] * r); asm volatile("" ::: "memory"); }
        }
    }
};
struct EpiProj {
    static constexpr bool PERM = true, AFTER_DRAIN = false;
    bf16_t* O; int ldo; const float* ssq; int sig_from; bf16_t* O2; int split_at; float qscale; int qtiles;
    __device__ __forceinline__ void operator()(AccRef acc, const Unit& u, int wr, int wc, int fr, int fq) const {
        asm volatile("" : "+v"(fr), "+v"(fq));
        const int row0 = u.pm * BM + wr * 64 + fr; const bool sig = u.pn >= sig_from;
        float rs[2][4];
        if (ssq) unit_rstd<4>(rs, ssq, 16, row0, fq, 1.0f / 1024.0f);
        else {
#pragma unroll
            for (int ai = 0; ai < 2; ++ai)
#pragma unroll
                for (int m = 0; m < 4; ++m) rs[ai][m] = 1.0f; }
        if (u.pn < qtiles) {
#pragma unroll
            for (int ai = 0; ai < 2; ++ai)
#pragma unroll
                for (int m = 0; m < 4; ++m) rs[ai][m] *= qscale; }
#pragma unroll
        for (int bj = 0; bj < 2; ++bj) { int c = u.pn * BM + bj * HALF + wc * 32 + 8 * fq; bf16_t* ob = O; if (c >= split_at) { c -= split_at; ob = O2; }
#pragma unroll
            for (int ai = 0; ai < 2; ++ai)
#pragma unroll
                for (int m = 0; m < 4; ++m) { const int row = row0 + ai * HALF + m * 16; const float r = rs[ai][m];
                    f32x4 v0 = acc[ai][bj][m][0] * r, v1 = acc[ai][bj][m][1] * r;
                    if (sig) {
#pragma unroll
                        for (int j = 0; j < 4; ++j) { v0[j] = sigmoidf_(v0[j]); v1[j] = sigmoidf_(v1[j]); } }
                    *(u32x4*)(ob + (size_t)row * ldo + c) = pack8(v0, v1); asm volatile("" ::: "memory"); }
        }
    }
};
template <int STEP> struct EpiBranch {
    static constexpr bool PERM = true, AFTER_DRAIN = false;
    bf16_t* PB;
    __device__ __forceinline__ void operator()(AccRef acc, const Unit& u, int wr, int wc, int fr, int fq) const {
        asm volatile("" : "+v"(fr), "+v"(fq));
        const int row0 = u.pm * BM + wr * 64 + fr;
#pragma unroll
        for (int bj = 0; bj < 2; ++bj) { const int c = u.pn * BM + bj * HALF + wc * 32 + 8 * fq;
#pragma unroll
            for (int ai = 0; ai < 2; ++ai)
#pragma unroll
                for (int m = 0; m < 4; ++m) { const int row = row0 + ai * HALF + m * 16; bf16_t* rp = PB + (size_t)row * 5120; float* tp = (float*)(rp + 1024) + c;
                    const u32x4 g = *(const u32x4*)(rp + (STEP == 0 ? 3072 : 4096) + c);
                    const f32x4 g0 = {bf_lo(g.x), bf_hi(g.x), bf_lo(g.y), bf_hi(g.y)}, g1 = {bf_lo(g.z), bf_hi(g.z), bf_lo(g.w), bf_hi(g.w)};
                    f32x4 v0 = acc[ai][bj][m][0] * g0, v1 = acc[ai][bj][m][1] * g1;
                    if (STEP == 0) { *(f32x4*)tp = v0; *(f32x4*)(tp + 4) = v1; }
                    else { v0 += *(const f32x4*)tp; v1 += *(const f32x4*)(tp + 4); *(u32x4*)(rp + 3072 + c) = pack8(v0, v1); }
                    asm volatile("" ::: "memory"); }
        }
    }
};
template <class Epi, class Sched, bool ALIGN_EPI = false, bool SP2 = false>
__device__ __forceinline__ void gemm_phase(PG8_LAS unsigned char* lds, const Gemm g, const Sched& S, const Epi& E) {
    int tid_ = threadIdx.x; asm volatile("" : "+v"(tid_));
    const int tid = tid_, wid = __builtin_amdgcn_readfirstlane(tid >> 6), lane = tid & 63, wr = wid >> 2, wc = wid & 3, fr = lane & 15, fq = lane >> 4;
    int K_ = g.K; asm volatile("" : "+s"(K_));
    const int K = K_, nt = K / BK;
    unsigned voffA, voffB;
    { int R, C; stage_rc(tid * 16, R, C); const int Rb = Epi::PERM ? ((R & ~31) + perm32(R & 31)) : R;
        voffA = (unsigned)(R * g.lda + C) * 2u; voffB = (unsigned)(Rb * K + C) * 2u; }
    const size_t r64A = (size_t)64 * g.lda * 2, r64B = (size_t)64 * K * 2;
    const size_t kstep = (size_t)(BK * 2);
    const size_t hstepA = (size_t)HALF * g.lda * 2, hstepB = (size_t)HALF * K * 2;
    const size_t tstepA = 2 * hstepA, tstepB = 2 * hstepB;
    const unsigned ldsw = (unsigned)wid * 1024u;
    const int aoff = lds_byte(wr * 64 + fr, fq * 8), boff = lds_byte(wc * 32 + fr, fq * 8);
#define PG8_SA(b, h) (((b) * 2 + (h)) * HTB)
#define PG8_SB(b, h) ((4 + (b) * 2 + (h)) * HTB)
#define PG8_STAGE(bufoff, gbase, W) do { _Pragma("unroll") for (int _i = 0; _i < 2; ++_i) \
        __builtin_amdgcn_global_load_lds((const unsigned*)((const char*)(gbase) + (size_t)_i * r64##W + voff##W), (PG8_LAS unsigned*)(lds + (bufoff) + ldsw + _i * 8192), 16, 0, 0); } while (0)
#define PG8_LDA(dst, b, h) do { _Pragma("unroll") for (int m = 0; m < 4; ++m) _Pragma("unroll") for (int k = 0; k < 2; ++k) dst[m][k] = *(const PG8_LAS bf16x8*)(lds + PG8_SA(b, h) + aoff + m * 2048 + k * 1024); } while (0)
#define PG8_LDB(dst, b, h) do { _Pragma("unroll") for (int n = 0; n < 2; ++n) _Pragma("unroll") for (int k = 0; k < 2; ++k) dst[n][k] = *(const PG8_LAS bf16x8*)(lds + PG8_SB(b, h) + boff + n * 2048 + k * 1024); } while (0)
#define PG8_MMA(ai, bj, At, Bt) do { __builtin_amdgcn_s_setprio(1); _Pragma("unroll") for (int m = 0; m < 4; ++m) _Pragma("unroll") for (int n = 0; n < 2; ++n) _Pragma("unroll") for (int k = 0; k < 2; ++k) \
        acc[ai][bj][m][n] = __builtin_amdgcn_mfma_f32_16x16x32_bf16(Bt[n][k], At[m][k], acc[ai][bj][m][n], 0, 0, 0); __builtin_amdgcn_s_setprio(0); } while (0)
#define PG8_WAIT_V(n) asm volatile("s_waitcnt vmcnt(" #n ")" ::: "memory")
#define PG8_WAIT_L(n) asm volatile("s_waitcnt lgkmcnt(" #n ")" ::: "memory")
#define PG8_BAR __builtin_amdgcn_s_barrier()
#define PG8_SCHED __builtin_amdgcn_sched_barrier(0)
    Unit cur, nxt; int ui = 0;
    if (!S.next(0, cur)) return;
    f32x4 acc[2][2][4][2];
#pragma unroll
    for (int a = 0; a < 2; ++a)
#pragma unroll
        for (int b = 0; b < 2; ++b)
#pragma unroll
            for (int m = 0; m < 4; ++m)
#pragma unroll
                for (int n = 0; n < 2; ++n) acc[a][b][m][n] = (f32x4){0.f, 0.f, 0.f, 0.f};
    bf16x8 At[4][2], B0[2][2], B1[2][2];
    const char* cA = (const char*)g.A + (size_t)cur.pm * tstepA; const char* cB = (const char*)g.Bt + (size_t)cur.pn * tstepB;
    S.a_ready(cur);
    if constexpr (SP2) {
        PG8_STAGE(PG8_SB(0, 0), cB, B); PG8_STAGE(PG8_SB(0, 1), cB + hstepB, B); PG8_STAGE(PG8_SA(0, 0), cA, A); PG8_STAGE(PG8_SA(0, 1), cA + hstepA, A);
        if (wr == 1) PG8_BAR;
        PG8_WAIT_V(2); PG8_BAR;
        PG8_STAGE(PG8_SB(1, 0), cB + kstep, B); PG8_STAGE(PG8_SA(1, 0), cA + kstep, A); PG8_STAGE(PG8_SB(1, 1), cB + hstepB + kstep, B);
        PG8_WAIT_V(6); PG8_BAR;
    } else {
        PG8_STAGE(PG8_SB(0, 0), cB, B); PG8_STAGE(PG8_SA(0, 0), cA, A); PG8_STAGE(PG8_SB(0, 1), cB + hstepB, B); PG8_STAGE(PG8_SA(0, 1), cA + hstepA, A);
        if (wr == 1) PG8_BAR;
        PG8_WAIT_V(4); PG8_BAR;
        PG8_STAGE(PG8_SB(1, 0), cB + kstep, B); PG8_STAGE(PG8_SA(1, 0), cA + kstep, A); PG8_STAGE(PG8_SB(1, 1), cB + hstepB + kstep, B);
        PG8_WAIT_V(6); PG8_BAR;
    }
    for (;;) {
        const bool has_next = S.next(ui + 1, nxt);
        const char* nA = has_next ? (const char*)g.A + (size_t)nxt.pm * tstepA : cA; const char* nB = has_next ? (const char*)g.Bt + (size_t)nxt.pn * tstepB : cB;
#pragma unroll 1
        for (int t = 0; t < nt; t += 2) {
            const bool last = (t == nt - 2);
            const char* a1 = cA + (size_t)(t + 1) * kstep;
            const char* a2 = last ? nA : cA + (size_t)(t + 2) * kstep; const char* b2 = last ? nB : cB + (size_t)(t + 2) * kstep;
            const char* a3 = a2 + kstep; const char* b3 = b2 + kstep;
            if (last && has_next) S.a_ready(nxt);
            if constexpr (SP2) {
            PG8_LDB(B0, 0, 0); PG8_LDB(B1, 0, 1); PG8_SCHED; PG8_LDA(At, 0, 0); PG8_STAGE(PG8_SA(1, 1), a1 + hstepA, A);
            PG8_WAIT_V(8); PG8_WAIT_L(0); PG8_BAR; PG8_MMA(0, 0, At, B0); PG8_MMA(0, 1, At, B1); PG8_BAR; PG8_SCHED;
            PG8_LDA(At, 0, 1); PG8_STAGE(PG8_SB(0, 0), b2, B); PG8_STAGE(PG8_SB(0, 1), b2 + hstepB, B); PG8_STAGE(PG8_SA(0, 0), a2, A);
            PG8_WAIT_V(8); PG8_WAIT_L(0); PG8_BAR; PG8_MMA(1, 0, At, B0); PG8_MMA(1, 1, At, B1); PG8_BAR; PG8_SCHED;
            PG8_LDB(B0, 1, 0); PG8_LDB(B1, 1, 1); PG8_SCHED; PG8_LDA(At, 1, 0); PG8_STAGE(PG8_SA(0, 1), a2 + hstepA, A);
            PG8_WAIT_V(8); PG8_WAIT_L(0); PG8_BAR; PG8_MMA(0, 0, At, B0); PG8_MMA(0, 1, At, B1); PG8_BAR; PG8_SCHED;
            PG8_LDA(At, 1, 1); PG8_STAGE(PG8_SB(1, 0), b3, B); PG8_STAGE(PG8_SB(1, 1), b3 + hstepB, B); PG8_STAGE(PG8_SA(1, 0), a3, A);
            PG8_WAIT_V(8); PG8_WAIT_L(0); PG8_BAR; PG8_MMA(1, 0, At, B0); PG8_MMA(1, 1, At, B1); PG8_BAR; PG8_SCHED;
            } else {
            PG8_LDB(B0, 0, 0); PG8_SCHED; PG8_LDA(At, 0, 0); PG8_STAGE(PG8_SA(1, 1), a1 + hstepA, A);
            PG8_WAIT_L(8); PG8_BAR; PG8_WAIT_L(0); PG8_MMA(0, 0, At, B0); PG8_BAR; PG8_SCHED;
            PG8_LDB(B1, 0, 1); PG8_STAGE(PG8_SB(0, 0), b2, B);
            PG8_BAR; PG8_WAIT_L(0); PG8_MMA(0, 1, At, B1); PG8_BAR;
            PG8_LDA(At, 0, 1); PG8_STAGE(PG8_SA(0, 0), a2, A);
            PG8_BAR; PG8_WAIT_L(0); PG8_MMA(1, 0, At, B0); PG8_BAR; PG8_SCHED;
            PG8_STAGE(PG8_SB(0, 1), b2 + hstepB, B);
            PG8_WAIT_V(6); PG8_BAR; PG8_MMA(1, 1, At, B1); PG8_BAR;
            PG8_LDB(B0, 1, 0); PG8_SCHED; PG8_LDA(At, 1, 0); PG8_STAGE(PG8_SA(0, 1), a2 + hstepA, A);
            PG8_WAIT_L(8); PG8_BAR; PG8_WAIT_L(0); PG8_MMA(0, 0, At, B0); PG8_BAR; PG8_SCHED;
            PG8_LDB(B1, 1, 1); PG8_STAGE(PG8_SB(1, 0), b3, B);
            PG8_BAR; PG8_WAIT_L(0); PG8_MMA(0, 1, At, B1); PG8_BAR;
            PG8_LDA(At, 1, 1); PG8_STAGE(PG8_SA(1, 0), a3, A);
            PG8_BAR; PG8_WAIT_L(0); PG8_MMA(1, 0, At, B0); PG8_BAR; PG8_SCHED;
            PG8_STAGE(PG8_SB(1, 1), b3 + hstepB, B);
            PG8_WAIT_V(6); PG8_BAR; PG8_MMA(1, 1, At, B1); PG8_BAR;
            }
        }
        if constexpr (ALIGN_EPI) { if (wr == 0) PG8_BAR; }
        if constexpr (!Epi::AFTER_DRAIN) { E(acc, cur, wr, wc, fr, fq); S.done(cur); }
        if (!has_next) break;
#pragma unroll
        for (int a = 0; a < 2; ++a)
#pragma unroll
            for (int b = 0; b < 2; ++b)
#pragma unroll
                for (int m = 0; m < 4; ++m)
#pragma unroll
                    for (int n = 0; n < 2; ++n) acc[a][b][m][n] = (f32x4){0.f, 0.f, 0.f, 0.f};
        cur = nxt; cA = nA; cB = nB; ++ui;
        if constexpr (ALIGN_EPI) { if (wr == 1) PG8_BAR; }
    }
    PG8_WAIT_V(0);
    if constexpr (!ALIGN_EPI) { if (wr == 0) PG8_BAR; }
    PG8_BAR;
    if constexpr (Epi::AFTER_DRAIN) { E.fused(acc, cur, wr, wc, fr, fq, lds, wid, lane); S.done(cur); }
#undef PG8_SA
#undef PG8_SB
#undef PG8_STAGE
#undef PG8_LDA
#undef PG8_LDB
#undef PG8_MMA
#undef PG8_WAIT_V
#undef PG8_WAIT_L
#undef PG8_BAR
#undef PG8_SCHED
}
}
namespace att {
typedef unsigned short bf16;
#define ATT_LAS __attribute__((address_space(3)))
using bf16x8 = __attribute__((ext_vector_type(8))) short;
using s16x4  = __attribute__((ext_vector_type(4))) short;
using f32x16 = __attribute__((ext_vector_type(16))) float;
using u32x4  = __attribute__((ext_vector_type(4))) unsigned;
typedef ATT_LAS char* lptr;
#define SBAR() __builtin_amdgcn_sched_barrier(0)
__device__ __forceinline__ int crow(int r, int hi) { return (r & 3) + 8 * (r >> 2) + 4 * hi; }
__device__ __forceinline__ unsigned cvtpk(float lo, float hi) { return pg8::cvt_pk_bf16(lo, hi); }
template <int DQK> __device__ __forceinline__ int kaddr(int row, int ch) { if constexpr (DQK == 64) return row * 128 + ((ch ^ ((row >> 1) & 7)) << 4); else return row * 256 + ((ch ^ (row & 15)) << 4); }
template <int NB> __device__ __forceinline__ int v_st(int k, int c) { const int kk = (k & ~0xC) | ((k & 4) << 1) | ((k & 8) >> 1); return ((kk >> 3) * NB + (c >> 5)) * 512 + ((kk & 7) * 32 + (c & 31)) * 2; }
__device__ __forceinline__ int v_rd_base(int lane) { return ((lane & 3) << 3) | (((lane >> 2) & 3) << 6) | (((lane >> 4) & 1) << 5) | (((lane >> 5) & 1) << 8); }
template <int NB> constexpr int v_rd_off(int d0, int ks, int half) { return ((2 * ks + half) * NB + d0) * 512; }
template <int OFF> __device__ __forceinline__ s16x4 tr_read(int vb) { s16x4 r; asm volatile("ds_read_b64_tr_b16 %0, %1 offset:%2" : "=&v"(r) : "v"(vb), "i"(OFF) : "memory"); return r; }
template <int NB, int D0> __device__ __forceinline__ void pv_one(f32x16& od, int vb, bf16x8 pa0, bf16x8 pa1, bf16x8 pa2, bf16x8 pa3) {
  const s16x4 l0 = tr_read<v_rd_off<NB>(D0, 0, 0)>(vb), h0 = tr_read<v_rd_off<NB>(D0, 0, 1)>(vb), l1 = tr_read<v_rd_off<NB>(D0, 1, 0)>(vb), h1 = tr_read<v_rd_off<NB>(D0, 1, 1)>(vb);
  const s16x4 l2 = tr_read<v_rd_off<NB>(D0, 2, 0)>(vb), h2 = tr_read<v_rd_off<NB>(D0, 2, 1)>(vb), l3 = tr_read<v_rd_off<NB>(D0, 3, 0)>(vb), h3 = tr_read<v_rd_off<NB>(D0, 3, 1)>(vb);
  asm volatile("s_waitcnt lgkmcnt(0)" ::: "memory"); SBAR();
#define ATT_PK(L, H) (bf16x8){L[0], L[1], L[2], L[3], H[0], H[1], H[2], H[3]}
  od = __builtin_amdgcn_mfma_f32_32x32x16_bf16(pa0, ATT_PK(l0, h0), od, 0, 0, 0);
  od = __builtin_amdgcn_mfma_f32_32x32x16_bf16(pa1, ATT_PK(l1, h1), od, 0, 0, 0);
  od = __builtin_amdgcn_mfma_f32_32x32x16_bf16(pa2, ATT_PK(l2, h2), od, 0, 0, 0);
  od = __builtin_amdgcn_mfma_f32_32x32x16_bf16(pa3, ATT_PK(l3, h3), od, 0, 0, 0);
#undef ATT_PK
}
template <int NB> __device__ __forceinline__ void pv_all(f32x16 (&o)[NB], int vb, bf16x8 pa0, bf16x8 pa1, bf16x8 pa2, bf16x8 pa3) {
  pv_one<NB, 0>(o[0], vb, pa0, pa1, pa2, pa3); pv_one<NB, 1>(o[1], vb, pa0, pa1, pa2, pa3);
  if constexpr (NB == 4) { pv_one<NB, 2>(o[2], vb, pa0, pa1, pa2, pa3); pv_one<NB, 3>(o[3], vb, pa0, pa1, pa2, pa3); }
}
template <int DQK> __device__ __forceinline__ void qkt(f32x16& p0, f32x16& p1, lptr Ks, const bf16x8 (&qr)[DQK / 16], int r32, int hi) {
  p0 = f32x16{}; p1 = f32x16{};
#pragma unroll
  for (int d0 = 0; d0 < DQK / 16; ++d0) {
    const bf16x8 b0 = *(const ATT_LAS bf16x8*)(Ks + kaddr<DQK>(r32, 2 * d0 + hi));
    const bf16x8 b1 = *(const ATT_LAS bf16x8*)(Ks + kaddr<DQK>(32 + r32, 2 * d0 + hi));
    p0 = __builtin_amdgcn_mfma_f32_32x32x16_bf16(b0, qr[d0], p0, 0, 0, 0);
    p1 = __builtin_amdgcn_mfma_f32_32x32x16_bf16(b1, qr[d0], p1, 0, 0, 0); }
}
template <bool BIAS> __device__ __forceinline__ void partialSM(f32x16& p0, f32x16& p1, float& m_reg, float& mn, float& alpha, const float C, const float thr_raw,
                                                               const bool masked, const bool biased, const ATT_LAS float* tb, const int relbase, const int hi) {
  if (masked) {
#pragma unroll
    for (int r = 0; r < 16; ++r) { p0[r] = -1e30f; p1[r] = -1e30f; }
  } else if (BIAS && biased) {
#pragma unroll
    for (int r = 0; r < 16; ++r) { const int i0 = relbase + crow(r, hi); p0[r] += tb[i0 < 0 ? 0 : i0]; p1[r] += tb[i0 + 32 < 0 ? 0 : i0 + 32]; }
  }
  float pmax = p0[0];
#pragma unroll
  for (int r = 1; r < 16; ++r) pmax = fmaxf(pmax, p0[r]);
#pragma unroll
  for (int r = 0; r < 16; ++r) pmax = fmaxf(pmax, p1[r]);
  { auto rr = __builtin_amdgcn_permlane32_swap(__float_as_uint(pmax), __float_as_uint(pmax), false, false);
    pmax = fmaxf(__uint_as_float(rr[0]), __uint_as_float(rr[1])); }
  if (__builtin_expect(__all(pmax - m_reg <= thr_raw), 1)) { mn = m_reg; alpha = 1.f; }
  else { mn = fmaxf(m_reg, pmax); alpha = __builtin_amdgcn_exp2f((m_reg - mn) * C); m_reg = mn; }
  const float mnC = -mn * C;
#pragma unroll
  for (int r = 0; r < 16; ++r) p0[r] = fmaf(p0[r], C, mnC);
#pragma unroll
  for (int r = 0; r < 16; ++r) p1[r] = fmaf(p1[r], C, mnC);
#pragma unroll
  for (int r = 0; r < 16; ++r) p0[r] = __builtin_amdgcn_exp2f(p0[r]);
}
__device__ __forceinline__ void finishSM(f32x16& p0, f32x16& p1, float alpha, float& l_reg, bf16x8& pa0, bf16x8& pa1, bf16x8& pa2, bf16x8& pa3) {
#pragma unroll
  for (int r = 0; r < 16; ++r) p1[r] = __builtin_amdgcn_exp2f(p1[r]);
  float ps = 0;
#pragma unroll
  for (int r = 0; r < 16; ++r) ps += p0[r];
#pragma unroll
  for (int r = 0; r < 16; ++r) ps += p1[r];
  { auto rr = __builtin_amdgcn_permlane32_swap(__float_as_uint(ps), __float_as_uint(ps), false, false);
    ps = __uint_as_float(rr[0]) + __uint_as_float(rr[1]); }
  l_reg = l_reg * alpha + ps;
#define ATT_PK4(P, BASE, OUT) do { unsigned a0 = cvtpk(P[BASE + 0], P[BASE + 1]), a1 = cvtpk(P[BASE + 2], P[BASE + 3]);   \
    unsigned b0 = cvtpk(P[BASE + 4], P[BASE + 5]), b1 = cvtpk(P[BASE + 6], P[BASE + 7]);                              \
    auto r0 = __builtin_amdgcn_permlane32_swap(a0, b0, false, false); auto r1 = __builtin_amdgcn_permlane32_swap(a1, b1, false, false); \
    u32x4 w = {r0[0], r1[0], r0[1], r1[1]}; OUT = __builtin_bit_cast(bf16x8, w); } while (0)
  ATT_PK4(p0, 0, pa0); ATT_PK4(p0, 8, pa1); ATT_PK4(p1, 0, pa2); ATT_PK4(p1, 8, pa3);
#undef ATT_PK4
}
template <int DQK, int DV> constexpr int core_lds() { return 2 * 64 * DV * 2 + 2 * 64 * (DQK == 64 ? 128 : 256) + 8 * 64 * 4; }

template <int DQK, int DV, int LDQ, int LDK, int LDV, bool CAUSAL, bool BIAS, int SD>
__device__ __forceinline__ void attn_core(const bf16* __restrict__ Qb, const bf16* __restrict__ Kh, const bf16* __restrict__ Vh, const int NT, const float C, const float thr_raw,
                                          const ATT_LAS float* tb, const int q0, lptr lds, f32x16 (&o)[DV / 32]) {
  constexpr int NB = DV / 32, ND = DQK / 16, KCH = DQK / 8, NKC = 64 * KCH, KIT = (NKC + 511) / 512, VCH = DV / 8, NVC = 64 * VCH, VIT = NVC / 512;
  constexpr int KBYTES = 64 * (DQK == 64 ? 128 : 256), VBYTES = 64 * DV * 2;
  int tid_ = threadIdx.x; asm volatile("" : "+v"(tid_));
  const int tid = tid_, lane = tid & 63, r32 = lane & 31, hi = lane >> 5; const int wid = __builtin_amdgcn_readfirstlane(tid >> 6);
  lptr V_lds = lds; lptr K_lds = lds + 2 * VBYTES;
  ATT_LAS float* ws = (ATT_LAS float*)(lds + 2 * VBYTES + 2 * KBYTES) + wid * 64; ATT_LAS float* li_l = ws; ATT_LAS float* al_l = ws + 32;
  float m_reg = -1e30f, l_reg = 0.f; bf16x8 qr[ND];
#pragma unroll
  for (int d = 0; d < NB; ++d) o[d] = f32x16{};
  const bf16* Qw = Qb + (long)(wid * 32 + r32) * LDQ + hi * 8;
#pragma unroll
  for (int d0 = 0; d0 < ND; ++d0) qr[d0] = *reinterpret_cast<const bf16x8*>(Qw + d0 * 16);
  int kg[KIT], kl[KIT], vg[VIT], vl[VIT];
#pragma unroll
  for (int it = 0; it < KIT; ++it) { const int idx = tid + 512 * it, row = idx / KCH, ch = idx % KCH; kg[it] = row * LDK + ch * 8; kl[it] = kaddr<DQK>(row & 63, ch); }
#pragma unroll
  for (int it = 0; it < VIT; ++it) { const int idx = tid + 512 * it, row = idx / VCH, ch = idx % VCH; vg[it] = row * LDV + ch * 8; vl[it] = v_st<NB>(row, ch * 8); }
  const int vb0 = (int)(unsigned)(uintptr_t)V_lds + v_rd_base(lane);
  struct { bf16x8 k[KIT]; bf16x8 v[VIT]; } sr_[SD];
  constexpr int SE = 0, SO = SD - 1;
#define SLOAD(i, k0) do { _Pragma("unroll") for (int it = 0; it < KIT; ++it) if (tid + 512 * it < NKC) sr_[i].k[it] = *reinterpret_cast<const bf16x8*>(Kh + (long)(k0) * LDK + kg[it]); \
    _Pragma("unroll") for (int it = 0; it < VIT; ++it) sr_[i].v[it] = *reinterpret_cast<const bf16x8*>(Vh + (long)(k0) * LDV + vg[it]); } while (0)
#define SWRITE(b, i) do { _Pragma("unroll") for (int it = 0; it < KIT; ++it) if (tid + 512 * it < NKC) *(ATT_LAS bf16x8*)(K_lds + (b) * KBYTES + kl[it]) = sr_[i].k[it]; \
    _Pragma("unroll") for (int it = 0; it < VIT; ++it) *(ATT_LAS bf16x8*)(V_lds + (b) * VBYTES + vl[it]) = sr_[i].v[it]; } while (0)
#define SWAIT() do { if constexpr (SD == 1) asm volatile("s_waitcnt vmcnt(0)" ::: "memory"); else if constexpr (NKC / 512 + VIT == 2) asm volatile("s_waitcnt vmcnt(2)" ::: "memory"); else if constexpr (NKC / 512 + VIT == 3) asm volatile("s_waitcnt vmcnt(3)" ::: "memory"); else asm volatile("s_waitcnt vmcnt(4)" ::: "memory"); } while (0)
#define RESC(a) do { if (__any((a) < 1.f)) { if (hi == 0) al_l[r32] = (a); asm volatile("s_waitcnt lgkmcnt(0)" ::: "memory"); \
    _Pragma("unroll") for (int d = 0; d < NB; ++d) _Pragma("unroll") for (int r = 0; r < 16; ++r) o[d][r] *= al_l[crow(r, hi)]; } } while (0)
#define TMASK(j) (CAUSAL && ((j) - (NT - 4)) > (wid >> 1))
#define TBIAS(j) (BIAS && (j) >= NT - 6)
#define RELB(j) (64 * (j) - (q0 + 32 * wid + r32) + 128)
  f32x16 pA0, pA1, pB0, pB1; float mnA, mnB, alA, alB; bf16x8 pa0, pa1, pa2, pa3;
  SLOAD(SE, 0); asm volatile("s_waitcnt vmcnt(0)" ::: "memory"); SWRITE(0, SE); __syncthreads();
  qkt<DQK>(pA0, pA1, K_lds, qr, r32, hi); partialSM<BIAS>(pA0, pA1, m_reg, mnA, alA, C, thr_raw, false, TBIAS(0), tb, RELB(0), hi);
  SLOAD(SO, 64); if constexpr (SD == 2) { if (2 < NT) SLOAD(SE, 128); }
  SWAIT(); SWRITE(1, SO); __syncthreads();
  for (int j = 1; j + 1 < NT; j += 2) {
    SBAR(); qkt<DQK>(pB0, pB1, K_lds + KBYTES, qr, r32, hi);
    finishSM(pA0, pA1, alA, l_reg, pa0, pa1, pa2, pa3); SBAR();
    SLOAD(SO, (j + SD) * 64); SBAR();
    pv_all<NB>(o, vb0, pa0, pa1, pa2, pa3); partialSM<BIAS>(pB0, pB1, m_reg, mnB, alB, C, thr_raw, TMASK(j), TBIAS(j), tb, RELB(j), hi);
    __syncthreads(); SWAIT(); SWRITE(0, SE);
    RESC(alB); __syncthreads();
    SBAR(); qkt<DQK>(pA0, pA1, K_lds, qr, r32, hi);
    finishSM(pB0, pB1, alB, l_reg, pa0, pa1, pa2, pa3); SBAR();
    if (SD == 1 || j + 3 < NT) SLOAD(SE, (j + 1 + SD) * 64); SBAR();
    pv_all<NB>(o, vb0 + VBYTES, pa0, pa1, pa2, pa3); partialSM<BIAS>(pA0, pA1, m_reg, mnA, alA, C, thr_raw, TMASK(j + 1), TBIAS(j + 1), tb, RELB(j + 1), hi);
    __syncthreads(); SWAIT(); SWRITE(1, SO);
    RESC(alA); __syncthreads();
  }
  SBAR(); qkt<DQK>(pB0, pB1, K_lds + KBYTES, qr, r32, hi);
  finishSM(pA0, pA1, alA, l_reg, pa0, pa1, pa2, pa3); SBAR();
  pv_all<NB>(o, vb0, pa0, pa1, pa2, pa3); partialSM<BIAS>(pB0, pB1, m_reg, mnB, alB, C, thr_raw, TMASK(NT - 1), TBIAS(NT - 1), tb, RELB(NT - 1), hi);
  __syncthreads(); RESC(alB);
  finishSM(pB0, pB1, alB, l_reg, pa0, pa1, pa2, pa3); SBAR();
  pv_all<NB>(o, vb0 + VBYTES, pa0, pa1, pa2, pa3);
  if (hi == 0) li_l[r32] = l_reg; asm volatile("s_waitcnt lgkmcnt(0)" ::: "memory");
#pragma unroll
  for (int r = 0; r < 16; ++r) { const float rl = __builtin_amdgcn_rcpf(li_l[crow(r, hi)]);
#pragma unroll
    for (int d = 0; d < NB; ++d) o[d][r] *= rl; }
  __syncthreads();
#undef SLOAD
#undef SWRITE
#undef SWAIT
#undef RESC
#undef TMASK
#undef TBIAS
#undef RELB
}
}
namespace att2 {
using att::bf16; using att::bf16x8; using att::s16x4; using att::f32x16; using att::u32x4; using att::lptr; using att::crow;
typedef short v4i16_t __attribute__((ext_vector_type(4)));
__device__ __forceinline__ void glds16(const void* gsrc, unsigned lds_dst) { unsigned keep;
  asm volatile("s_mov_b32 %0, m0\n\ts_mov_b32 m0, %2\n\ts_nop 0\n\tglobal_load_lds_dwordx4 %1, off\n\ts_mov_b32 m0, %0" : "=&s"(keep) : "v"(gsrc), "s"(lds_dst) : "memory"); }
__device__ __forceinline__ s16x4 vtr(ATT_LAS const char* p) { return __builtin_bit_cast(s16x4, __builtin_amdgcn_ds_read_tr16_b64_v4i16((ATT_LAS v4i16_t*)p)); }
#define A2_BAR() do { __builtin_amdgcn_sched_barrier(0); asm volatile("s_waitcnt lgkmcnt(0)\n\ts_barrier" ::: "memory"); __builtin_amdgcn_sched_barrier(0); } while (0)
template <int DQK, int DV> constexpr int core_lds() { return 3 * 64 * DQK * 2 + 3 * 64 * DV * 2 + 8 * 64 * 4; }

template <int DQK, int DV, int LDQ, int LDK, int LDV, bool CAUSAL, bool BIAS>
__device__ __forceinline__ void attn_core(const bf16* __restrict__ Qb, const bf16* __restrict__ Kh, const bf16* __restrict__ Vh, const int NT, const float C, const float thr_raw,
                                          const ATT_LAS float* tb, const int q0, lptr lds, f32x16 (&o)[DV / 32], const int dbg = 0) {
  constexpr int NB = DV / 32, ND = DQK / 16, NKP = DQK / 8, NVP = DV / 4 / 2 * 2 / 2;
  constexpr int KSLOT = 64 * DQK * 2, VSLOT = 64 * DV * 2;
  static_assert(NVP == DV / 8 && (NVP == 8 || NVP == 16) && NKP >= 8 && NKP <= 16, "piece counts");
  int tid_ = threadIdx.x; asm volatile("" : "+v"(tid_));
  const int tid = tid_, lane = tid & 63, r32 = lane & 31, hi = lane >> 5; const int wid = __builtin_amdgcn_readfirstlane(tid >> 6); const int half = wid >> 2;
  const unsigned lds0 = (unsigned)(uintptr_t)lds;
  lptr K_ring = lds, V_ring = lds + 3 * KSLOT;
  ATT_LAS float* ws = (ATT_LAS float*)(lds + 3 * KSLOT + 3 * VSLOT) + wid * 64; ATT_LAS float* li_l = ws; ATT_LAS float* al_l = ws + 32;
  const bf16* ksrc0 = Kh + (long)lane * LDK + wid * 8;
  const bf16* vsrc0 = Vh + (long)(16 * (wid & 3) + (lane >> 2)) * LDV + (wid >> 2) * 32 + (lane & 3) * 8;
  const unsigned kdst0 = lds0 + wid * 1024, vdst0 = lds0 + 3 * KSLOT + wid * 1024;
  const bool k2 = (wid + 8 < NKP);
#define A2_DMA_K(t, slot) do { glds16(ksrc0 + (long)(t) * 64 * LDK, (unsigned)__builtin_amdgcn_readfirstlane(kdst0 + (slot) * KSLOT)); \
    if (NKP > 8 && k2) glds16(ksrc0 + (long)(t) * 64 * LDK + 64, (unsigned)__builtin_amdgcn_readfirstlane(kdst0 + (slot) * KSLOT + 8192)); } while (0)
#define A2_DMA_V(t, slot) do { glds16(vsrc0 + (long)(t) * 64 * LDV, (unsigned)__builtin_amdgcn_readfirstlane(vdst0 + (slot) * VSLOT)); \
    if (NVP > 8) glds16(vsrc0 + (long)(t) * 64 * LDV + 64, (unsigned)__builtin_amdgcn_readfirstlane(vdst0 + (slot) * VSLOT + 8192)); } while (0)
#define A2_WAITN() do { if constexpr (NKP == 8 && NVP == 8) asm volatile("s_waitcnt vmcnt(2)" ::: "memory"); \
    else if constexpr (NKP == 8 && NVP == 16) asm volatile("s_waitcnt vmcnt(3)" ::: "memory"); \
    else if constexpr (NKP == 16 && NVP == 16) asm volatile("s_waitcnt vmcnt(4)" ::: "memory"); \
    else { if (k2) asm volatile("s_waitcnt vmcnt(3)" ::: "memory"); else asm volatile("s_waitcnt vmcnt(2)" ::: "memory"); } } while (0)
  static_assert((NKP == 8 || NKP == 16 || (NKP == 12 && NVP == 8)), "wait counts cover these shapes");
  const unsigned kb0 = lds0 + hi * 1024 + r32 * 16;
  const unsigned vb0 = lds0 + 3 * KSLOT + ((lane >> 4) & 1) * 32 + (lane & 3) * 8 + (4 * hi + ((lane & 15) >> 2)) * 64;
  A2_DMA_K(0, 0); A2_DMA_V(0, 0); if (1 < NT) A2_DMA_K(1, 1);
  bf16x8 qr[ND];
  { const bf16* Qw = Qb + (long)(wid * 32 + r32) * LDQ + hi * 8;
#pragma unroll
    for (int d0 = 0; d0 < ND; ++d0) qr[d0] = *reinterpret_cast<const bf16x8*>(Qw + d0 * 16);
#pragma unroll
    for (int d0 = 0; d0 < ND; ++d0) asm volatile("" : "+v"(qr[d0])); }
#pragma unroll
  for (int d = 0; d < NB; ++d) o[d] = f32x16{};
  float m_reg = -1e30f, l_reg = 0.f; f32x16 p0, p1; bf16x8 pa[4];
  asm volatile("s_waitcnt vmcnt(0)" ::: "memory"); A2_BAR();
#define A2_KRD(kbv) do { _Pragma("unroll") for (int d0 = 0; d0 < ND; ++d0) { \
      asm volatile("ds_read_b128 %0, %1 offset:%2" : "=&v"(kf[2 * d0]) : "v"(kbv), "i"(d0 * 2048) : "memory"); \
      asm volatile("ds_read_b128 %0, %1 offset:%2" : "=&v"(kf[2 * d0 + 1]) : "v"(kbv), "i"(d0 * 2048 + 512) : "memory"); } } while (0)
#define A2_VRD(buf, vbv, dh) do { _Pragma("unroll") for (int ks = 0; ks < 4; ++ks) { \
      asm volatile("ds_read_b64_tr_b16 %0, %1 offset:%2" : "=&v"(vl##buf[ks]) : "v"(vbv), "i"((dh) * 4096 + ks * 1024) : "memory"); \
      asm volatile("ds_read_b64_tr_b16 %0, %1 offset:%2" : "=&v"(vh##buf[ks]) : "v"(vbv), "i"((dh) * 4096 + ks * 1024 + 512) : "memory"); } } while (0)
#define A2_LW(n) do { asm volatile("s_waitcnt lgkmcnt(" #n ")" ::: "memory"); __builtin_amdgcn_sched_barrier(0); } while (0)
#define A2_QKM() do { p0 = f32x16{}; p1 = f32x16{}; _Pragma("unroll") for (int d0 = 0; d0 < ND; ++d0) { \
      p0 = __builtin_amdgcn_mfma_f32_32x32x16_bf16(kf[2 * d0], qr[d0], p0, 0, 0, 0); p1 = __builtin_amdgcn_mfma_f32_32x32x16_bf16(kf[2 * d0 + 1], qr[d0], p1, 0, 0, 0); } } while (0)
#define A2_PVM(buf, dh) do { _Pragma("unroll") for (int ks = 0; ks < 4; ++ks) \
      o[dh] = __builtin_amdgcn_mfma_f32_32x32x16_bf16(pa[ks], (bf16x8){vl##buf[ks][0], vl##buf[ks][1], vl##buf[ks][2], vl##buf[ks][3], vh##buf[ks][0], vh##buf[ks][1], vh##buf[ks][2], vh##buf[ks][3]}, o[dh], 0, 0, 0); } while (0)
#define A2_SB() __builtin_amdgcn_sched_barrier(0)
#define A2_QKM1(d0) do { p0 = __builtin_amdgcn_mfma_f32_32x32x16_bf16(kf[2 * (d0)], qr[d0], p0, 0, 0, 0); p1 = __builtin_amdgcn_mfma_f32_32x32x16_bf16(kf[2 * (d0) + 1], qr[d0], p1, 0, 0, 0); } while (0)
#define A2_VRD1(buf, vbv, dh, ks) do { \
      asm volatile("ds_read_b64_tr_b16 %0, %1 offset:%2" : "=&v"(vl##buf[ks]) : "v"(vbv), "i"((dh) * 4096 + (ks) * 1024) : "memory"); \
      asm volatile("ds_read_b64_tr_b16 %0, %1 offset:%2" : "=&v"(vh##buf[ks]) : "v"(vbv), "i"((dh) * 4096 + (ks) * 1024 + 512) : "memory"); } while (0)
#define A2_LWV(n) do { asm volatile("s_waitcnt lgkmcnt(%0)" :: "i"(n) : "memory"); __builtin_amdgcn_sched_barrier(0); } while (0)
#define A2_PVREST(vbv) do { A2_LW(0); A2_VRD(B, vbv, 1); A2_PVM(A, 0); A2_SB(); \
    if constexpr (NB > 2) { A2_LW(0); A2_VRD(A, vbv, 2); A2_PVM(B, 1); A2_SB(); A2_LW(0); A2_VRD(B, vbv, 3); A2_PVM(A, 2); A2_SB(); A2_LW(0); A2_PVM(B, 3); A2_SB(); } \
    else { A2_LW(0); A2_PVM(B, 1); A2_SB(); } } while (0)
#define A2_M_Q(tq) do { __builtin_amdgcn_s_setprio(1); bf16x8 kf[2 * ND]; const unsigned kbv_ = kb0 + ((tq) % 3) * KSLOT; A2_KRD(kbv_); p0 = f32x16{}; p1 = f32x16{}; \
    _Pragma("unroll") for (int d0 = 0; d0 < ND; ++d0) { A2_LWV(2 * ND - 2 * d0 - 2); A2_QKM1(d0); A2_SB(); } __builtin_amdgcn_s_setprio(0); } while (0)
#define A2_M_P(tv) do { __builtin_amdgcn_s_setprio(1); s16x4 vlA[4], vhA[4], vlB[4], vhB[4]; const unsigned vbv_ = vb0 + ((tv) % 3) * VSLOT; A2_VRD(A, vbv_, 0); A2_PVREST(vbv_); __builtin_amdgcn_s_setprio(0); } while (0)
#define A2_M_QP(tq, tv) do { bf16x8 kf[2 * ND]; s16x4 vlA[4], vhA[4], vlB[4], vhB[4]; const unsigned kbv_ = kb0 + ((tq) % 3) * KSLOT, vbv_ = vb0 + ((tv) % 3) * VSLOT; \
    A2_KRD(kbv_); p0 = f32x16{}; p1 = f32x16{}; \
    _Pragma("unroll") for (int d0 = 0; d0 < ND; ++d0) { A2_LWV((2 * ND - 2 * d0 - 2) + (2 * d0 < 8 ? 2 * d0 : 8)); A2_QKM1(d0); A2_SB(); if (d0 < 4) { A2_VRD1(A, vbv_, 0, d0); } A2_SB(); } \
    A2_PVREST(vbv_); } while (0)
#define A2_SOFT(t) do { const int t_ = (t); \
    if (CAUSAL && (t_ - (NT - 4)) > (wid >> 1)) { _Pragma("unroll") for (int r = 0; r < 16; ++r) { p0[r] = -1e30f; p1[r] = -1e30f; } } \
    else if (BIAS && t_ >= NT - 6) { const int rb_ = 64 * t_ - (q0 + 32 * wid + r32) + 128; \
      _Pragma("unroll") for (int r = 0; r < 16; ++r) { const int i0 = rb_ + crow(r, hi); p0[r] += tb[i0 < 0 ? 0 : i0]; p1[r] += tb[i0 + 32 < 0 ? 0 : i0 + 32]; } } \
    float pmax = p0[0]; \
    _Pragma("unroll") for (int r = 1; r < 16; ++r) pmax = fmaxf(pmax, p0[r]); \
    _Pragma("unroll") for (int r = 0; r < 16; ++r) pmax = fmaxf(pmax, p1[r]); \
    { auto rr = __builtin_amdgcn_permlane32_swap(__float_as_uint(pmax), __float_as_uint(pmax), false, false); pmax = fmaxf(__uint_as_float(rr[0]), __uint_as_float(rr[1])); } \
    float alpha = 1.f; \
    if (!__builtin_expect(__all(pmax - m_reg <= thr_raw), 1)) { const float mn = fmaxf(m_reg, pmax); alpha = __builtin_amdgcn_exp2f((m_reg - mn) * C); m_reg = mn; \
      if (hi == 0) al_l[r32] = alpha; asm volatile("s_waitcnt lgkmcnt(0)" ::: "memory"); \
      _Pragma("unroll") for (int d = 0; d < NB; ++d) _Pragma("unroll") for (int r = 0; r < 16; ++r) o[d][r] *= al_l[crow(r, hi)]; } \
    const float mnC = -m_reg * C; float ps = 0.f; \
    _Pragma("unroll") for (int r = 0; r < 16; ++r) { p0[r] = __builtin_amdgcn_exp2f(fmaf(p0[r], C, mnC)); p1[r] = __builtin_amdgcn_exp2f(fmaf(p1[r], C, mnC)); } \
    _Pragma("unroll") for (int r = 0; r < 16; ++r) ps += p0[r] + p1[r]; \
    { auto rr = __builtin_amdgcn_permlane32_swap(__float_as_uint(ps), __float_as_uint(ps), false, false); ps = __uint_as_float(rr[0]) + __uint_as_float(rr[1]); } \
    l_reg = l_reg * alpha + ps; \
    { u32x4 w0 = {att::cvtpk(p0[0], p0[1]), att::cvtpk(p0[2], p0[3]), att::cvtpk(p0[4], p0[5]), att::cvtpk(p0[6], p0[7])}; pa[0] = __builtin_bit_cast(bf16x8, w0); \
      u32x4 w1 = {att::cvtpk(p0[8], p0[9]), att::cvtpk(p0[10], p0[11]), att::cvtpk(p0[12], p0[13]), att::cvtpk(p0[14], p0[15])}; pa[1] = __builtin_bit_cast(bf16x8, w1); \
      u32x4 w2 = {att::cvtpk(p1[0], p1[1]), att::cvtpk(p1[2], p1[3]), att::cvtpk(p1[4], p1[5]), att::cvtpk(p1[6], p1[7])}; pa[2] = __builtin_bit_cast(bf16x8, w2); \
      u32x4 w3 = {att::cvtpk(p1[8], p1[9]), att::cvtpk(p1[10], p1[11]), att::cvtpk(p1[12], p1[13]), att::cvtpk(p1[14], p1[15])}; pa[3] = __builtin_bit_cast(bf16x8, w3); } } while (0)
#define A2_ISSUE(u) do { if (!(dbg & 1)) { if ((u) + 2 < NT) A2_DMA_K((u) + 2, ((u) + 2) % 3); if ((u) + 1 < NT) A2_DMA_V((u) + 1, ((u) + 1) % 3); } } while (0)
#define A2_ENDODD(t) do { if ((t) + 3 < NT) A2_WAITN(); else asm volatile("s_waitcnt vmcnt(0)" ::: "memory"); A2_BAR(); } while (0)
  if (half == 0) {
    A2_ISSUE(0); A2_M_Q(0); A2_BAR();
#pragma unroll 1
    for (int t = 0; t < NT; ++t) {
      if (!(dbg & 2)) { A2_SOFT(t); } A2_ENDODD(t);
      A2_ISSUE(t + 1);
      if (!(dbg & 4)) { if (t + 1 < NT) { A2_M_Q(t + 1); } A2_M_P(t); }
      A2_BAR();
    }
    A2_BAR();
  } else {
    A2_ISSUE(0); A2_BAR();
#pragma unroll 1
    for (int t = 0; t < NT; ++t) {
      if (!(dbg & 4)) { A2_M_Q(t); if (t > 0) { A2_M_P(t - 1); } } A2_ENDODD(t);
      A2_ISSUE(t + 1); if (!(dbg & 2)) { A2_SOFT(t); } A2_BAR();
    }
    A2_M_P(NT - 1); A2_BAR();
  }
  if (hi == 0) li_l[r32] = l_reg; asm volatile("s_waitcnt lgkmcnt(0)" ::: "memory");
#pragma unroll
  for (int r = 0; r < 16; ++r) { const float rl = __builtin_amdgcn_rcpf(li_l[crow(r, hi)]);
#pragma unroll
    for (int d = 0; d < NB; ++d) o[d][r] *= rl; }
#undef A2_DMA_K
#undef A2_DMA_V
#undef A2_WAITN
#undef A2_KRD
#undef A2_VRD
#undef A2_LW
#undef A2_QKM
#undef A2_PVM
#undef A2_SB
#undef A2_QKM1
#undef A2_VRD1
#undef A2_LWV
#undef A2_PVREST
#undef A2_M_Q
#undef A2_M_P
#undef A2_M_QP
#undef A2_SOFT
#undef A2_ISSUE
#undef A2_ENDODD
}
}
namespace att3 {
using att::bf16; using att::bf16x8; using att::s16x4; using att::f32x16; using att::u32x4; using att::lptr; using att::crow;
using att2::glds16; using att2::vtr;
template <int DQK, int DV> constexpr int core_lds() { return 3 * 64 * DQK * 2 + 3 * 64 * DV * 2 + 8 * 64 * 4; }
#define A3_SB() __builtin_amdgcn_sched_barrier(0)
#define A3_SGB(mask, n) __builtin_amdgcn_sched_group_barrier(mask, n, 0)

template <int DQK, int DV, int LDQ, int LDK, int LDV, bool CAUSAL, bool BIAS>
__device__ __forceinline__ void attn_core(const bf16* __restrict__ Qb, const bf16* __restrict__ Kh, const bf16* __restrict__ Vh, const int NT, const float C, const float thr_raw,
                                          const ATT_LAS float* tb, const int q0, lptr lds, f32x16 (&o)[DV / 32], const int dbg = 0) {
  constexpr int NB = DV / 32, ND = DQK / 16, NKP = DQK / 8, NVP = DV / 8;
  constexpr int KSLOT = 64 * DQK * 2, VSLOT = 64 * DV * 2;
  static_assert((NVP == 8 || NVP == 16) && (NKP == 8 || NKP == 12 || NKP == 16), "piece counts");
  int tid_ = threadIdx.x; asm volatile("" : "+v"(tid_));
  const int tid = tid_, lane = tid & 63, r32 = lane & 31, hi = lane >> 5; const int wid = __builtin_amdgcn_readfirstlane(tid >> 6);
  const unsigned lds0 = (unsigned)(uintptr_t)lds;
  ATT_LAS float* ws = (ATT_LAS float*)(lds + 3 * KSLOT + 3 * VSLOT) + wid * 64; ATT_LAS float* li_l = ws; ATT_LAS float* al_l = ws + 32;
  const bf16* ksrc0 = Kh + (long)lane * LDK + wid * 8;
  const bf16* vsrc0 = Vh + (long)(16 * (wid & 3) + (lane >> 2)) * LDV + (wid >> 2) * 32 + (lane & 3) * 8;
  const unsigned kdst0 = lds0 + wid * 1024, vdst0 = lds0 + 3 * KSLOT + wid * 1024;
  const bool k2 = (wid + 8 < NKP);
#define A3_DMA_K(t, slot) do { glds16(ksrc0 + (long)(t) * 64 * LDK, (unsigned)__builtin_amdgcn_readfirstlane(kdst0 + (slot) * KSLOT)); \
    if (NKP > 8 && k2) glds16(ksrc0 + (long)(t) * 64 * LDK + 64, (unsigned)__builtin_amdgcn_readfirstlane(kdst0 + (slot) * KSLOT + 8192)); } while (0)
#define A3_DMA_V(t, slot) do { glds16(vsrc0 + (long)(t) * 64 * LDV, (unsigned)__builtin_amdgcn_readfirstlane(vdst0 + (slot) * VSLOT)); \
    if (NVP > 8) glds16(vsrc0 + (long)(t) * 64 * LDV + 64, (unsigned)__builtin_amdgcn_readfirstlane(vdst0 + (slot) * VSLOT + 8192)); } while (0)
#define A3_WAITN() do { if constexpr (NKP == 8 && NVP == 8) asm volatile("s_waitcnt vmcnt(2)" ::: "memory"); \
    else if constexpr (NKP == 8 && NVP == 16) asm volatile("s_waitcnt vmcnt(3)" ::: "memory"); \
    else if constexpr (NKP == 16 && NVP == 16) asm volatile("s_waitcnt vmcnt(4)" ::: "memory"); \
    else if constexpr (NKP == 16 && NVP == 8) asm volatile("s_waitcnt vmcnt(3)" ::: "memory"); \
    else if constexpr (NVP == 8) { if (k2) asm volatile("s_waitcnt vmcnt(3)" ::: "memory"); else asm volatile("s_waitcnt vmcnt(2)" ::: "memory"); } \
    else { if (k2) asm volatile("s_waitcnt vmcnt(4)" ::: "memory"); else asm volatile("s_waitcnt vmcnt(3)" ::: "memory"); } } while (0)
  const unsigned kb0 = lds0 + hi * 1024 + r32 * 16;
  const unsigned vb0 = lds0 + 3 * KSLOT + ((lane >> 4) & 1) * 32 + (lane & 3) * 8 + (4 * hi + ((lane & 15) >> 2)) * 64;
  A3_DMA_K(0, 0); A3_DMA_V(0, 0); if (1 < NT) { A3_DMA_K(1, 1); A3_DMA_V(1, 1); } if (2 < NT) A3_DMA_K(2, 2);
  bf16x8 qr[ND];
  { const bf16* Qw = Qb + (long)(wid * 32 + r32) * LDQ + hi * 8;
#pragma unroll
    for (int d0 = 0; d0 < ND; ++d0) qr[d0] = *reinterpret_cast<const bf16x8*>(Qw + d0 * 16);
#pragma unroll
    for (int d0 = 0; d0 < ND; ++d0) asm volatile("" : "+v"(qr[d0])); }
#pragma unroll
  for (int d = 0; d < NB; ++d) o[d] = f32x16{};
  float mhat = 0.f, fresc = 1.f; bool resc = false;
  f32x16 pA0, pA1, pB0, pB1; bf16x8 pa[4]; f32x16 negm = f32x16{}, ol = f32x16{};
  const bf16x8 ones = {0x3F80, 0x3F80, 0x3F80, 0x3F80, 0x3F80, 0x3F80, 0x3F80, 0x3F80};
  asm volatile("s_waitcnt vmcnt(0) lgkmcnt(0)\n\ts_barrier" ::: "memory");
#define A3_QK(C0, C1, t) do { unsigned kbv_ = kb0 + ((t) % 3) * KSLOT; asm volatile("" : "+v"(kbv_)); \
    _Pragma("unroll") for (int d0 = 0; d0 < ND; ++d0) { const bf16x8 b0_ = *(const ATT_LAS bf16x8*)(uintptr_t)(kbv_ + d0 * 2048), b1_ = *(const ATT_LAS bf16x8*)(uintptr_t)(kbv_ + d0 * 2048 + 512); \
      if (d0 == 0) { C0 = __builtin_amdgcn_mfma_f32_32x32x16_bf16(b0_, qr[0], negm, 0, 0, 0); C1 = __builtin_amdgcn_mfma_f32_32x32x16_bf16(b1_, qr[0], negm, 0, 0, 0); } \
      else { C0 = __builtin_amdgcn_mfma_f32_32x32x16_bf16(b0_, qr[d0], C0, 0, 0, 0); C1 = __builtin_amdgcn_mfma_f32_32x32x16_bf16(b1_, qr[d0], C1, 0, 0, 0); } } } while (0)
#define A3_FIN(P0, P1) do { \
    { u32x4 w0 = {att::cvtpk(P0[0], P0[1]), att::cvtpk(P0[2], P0[3]), att::cvtpk(P0[4], P0[5]), att::cvtpk(P0[6], P0[7])}; pa[0] = __builtin_bit_cast(bf16x8, w0); \
      u32x4 w1 = {att::cvtpk(P0[8], P0[9]), att::cvtpk(P0[10], P0[11]), att::cvtpk(P0[12], P0[13]), att::cvtpk(P0[14], P0[15])}; pa[1] = __builtin_bit_cast(bf16x8, w1); \
      u32x4 w2 = {att::cvtpk(P1[0], P1[1]), att::cvtpk(P1[2], P1[3]), att::cvtpk(P1[4], P1[5]), att::cvtpk(P1[6], P1[7])}; pa[2] = __builtin_bit_cast(bf16x8, w2); \
      u32x4 w3 = {att::cvtpk(P1[8], P1[9]), att::cvtpk(P1[10], P1[11]), att::cvtpk(P1[12], P1[13]), att::cvtpk(P1[14], P1[15])}; pa[3] = __builtin_bit_cast(bf16x8, w3); } } while (0)
#define A3_MID(C0, C1, t, FIRST) do { const int t_ = (t); \
    if (CAUSAL && (t_ - (NT - 4)) > (wid >> 1)) { _Pragma("unroll") for (int r = 0; r < 16; ++r) { C0[r] = -1e30f; C1[r] = -1e30f; } } \
    else if (BIAS && t_ >= NT - 6) { const int rb_ = 64 * t_ - (q0 + 32 * wid + r32) + 128; \
      _Pragma("unroll") for (int r = 0; r < 16; ++r) { const int i0 = rb_ + crow(r, hi); C0[r] += tb[i0 < 0 ? 0 : i0]; C1[r] += tb[i0 + 32 < 0 ? 0 : i0 + 32]; } } \
    float pmax = C0[0]; \
    _Pragma("unroll") for (int r = 1; r < 16; ++r) pmax = fmaxf(pmax, C0[r]); \
    _Pragma("unroll") for (int r = 0; r < 16; ++r) pmax = fmaxf(pmax, C1[r]); \
    { auto rr = __builtin_amdgcn_permlane32_swap(__float_as_uint(pmax), __float_as_uint(pmax), false, false); pmax = fmaxf(__uint_as_float(rr[0]), __uint_as_float(rr[1])); } \
    resc = false; \
    if (FIRST || !__builtin_expect(__all(pmax <= thr_raw), 1)) { const float dl = FIRST ? pmax : fmaxf(pmax, 0.f); mhat += dl; \
      _Pragma("unroll") for (int r = 0; r < 16; ++r) { C0[r] -= dl; C1[r] -= dl; } \
      _Pragma("unroll") for (int r = 0; r < 16; ++r) negm[r] = -mhat; \
      if (!FIRST) { fresc = __builtin_amdgcn_exp2f(-dl); if (hi == 0) al_l[r32] = fresc; resc = true; } } } while (0)
#define A3_PVEXP(DOPV, tv, DOEXP, C0, C1) do { unsigned vbv_ = vb0 + ((tv) % 3) * VSLOT; asm volatile("" : "+v"(vbv_)); \
    if (DOPV) { _Pragma("unroll") for (int dh = 0; dh < NB; ++dh) _Pragma("unroll") for (int ks = 0; ks < 4; ++ks) { \
      const s16x4 lo_ = vtr((ATT_LAS const char*)(uintptr_t)(vbv_ + dh * 4096 + ks * 1024)), hi_ = vtr((ATT_LAS const char*)(uintptr_t)(vbv_ + dh * 4096 + ks * 1024 + 512)); \
      o[dh] = __builtin_amdgcn_mfma_f32_32x32x16_bf16(pa[ks], __builtin_shufflevector(lo_, hi_, 0, 1, 2, 3, 4, 5, 6, 7), o[dh], 0, 0, 0); } \
      _Pragma("unroll") for (int ks = 0; ks < 4; ++ks) ol = __builtin_amdgcn_mfma_f32_32x32x16_bf16(pa[ks], ones, ol, 0, 0, 0); } \
    if (DOEXP) { _Pragma("unroll") for (int r = 0; r < 16; ++r) { C0[r] = __builtin_amdgcn_exp2f(C0[r]); C1[r] = __builtin_amdgcn_exp2f(C1[r]); } } } while (0)
#define A3_PIN4() asm volatile("" : "+v"(pa[0]), "+v"(pa[1]), "+v"(pa[2]), "+v"(pa[3]))
#define A3_RESC() do { if (resc) { asm volatile("s_waitcnt lgkmcnt(0)" ::: "memory"); \
    _Pragma("unroll") for (int r = 0; r < 16; ++r) { const float f_ = al_l[crow(r, hi)]; ol[r] *= f_; _Pragma("unroll") for (int d = 0; d < NB; ++d) o[d][r] *= f_; } } } while (0)
#define A3_END(t) do { A3_SB(); if ((t) + 2 < NT) A3_WAITN(); else asm volatile("s_waitcnt vmcnt(0)" ::: "memory"); asm volatile("s_waitcnt lgkmcnt(0)\n\ts_barrier" ::: "memory"); A3_SB(); \
    if (!(dbg & 1)) { if ((t) + 3 < NT) A3_DMA_K((t) + 3, (t) % 3); if ((t) + 2 < NT) A3_DMA_V((t) + 2, ((t) + 2) % 3); } A3_RESC(); } while (0)
#define A3_MIX(npre, nm, nv, nd) do { A3_SGB(0x100, npre); _Pragma("unroll") for (int i_ = 0; i_ < (nm); ++i_) { A3_SGB(0x008, 1); if ((nd) > 0) A3_SGB(0x100, nd); A3_SGB(0x002, nv); } } while (0)
#define A3_STEP(C0, C1, P0, P1, t) do { \
    A3_SB(); if (!(dbg & 4)) { A3_QK(C0, C1, t); } A3_FIN(P0, P1); A3_PIN4(); A3_MIX(2 * ND, 2 * ND, (16 + 2 * ND - 1) / (2 * ND), 0); A3_SB(); \
    if (!(dbg & 16)) { A3_MID(C0, C1, t, false); } A3_SB(); \
    A3_PVEXP(!(dbg & 8), (t) - 1, !(dbg & 2), C0, C1); asm volatile("" : "+v"(C0), "+v"(C1)); A3_MIX(8, 4 * NB + 4, (32 + 4 * NB + 3) / (4 * NB + 4), 2); \
    A3_END(t); } while (0)
  A3_SB(); A3_QK(pA0, pA1, 0); A3_SB(); A3_MID(pA0, pA1, 0, true); A3_SB(); A3_PVEXP(false, 0, true, pA0, pA1); A3_END(0);
  int t = 1;
#pragma unroll 1
  for (; t + 1 < NT; t += 2) { A3_STEP(pB0, pB1, pA0, pA1, t); A3_STEP(pA0, pA1, pB0, pB1, t + 1); }
  A3_STEP(pB0, pB1, pA0, pA1, t);
  A3_SB(); A3_FIN(pB0, pB1); A3_SB(); A3_PVEXP(true, NT - 1, false, pB0, pB1); A3_SB();
#pragma unroll
  for (int r = 0; r < 16; ++r) { const float rl = __builtin_amdgcn_rcpf(ol[r]);
#pragma unroll
    for (int d = 0; d < NB; ++d) o[d][r] *= rl; }
  asm volatile("s_waitcnt lgkmcnt(0)\n\ts_barrier" ::: "memory");
#undef A3_DMA_K
#undef A3_DMA_V
#undef A3_WAITN
#undef A3_QK
#undef A3_FIN
#undef A3_MID
#undef A3_PVEXP
#undef A3_RESC
#undef A3_PIN4
#undef A3_END
#undef A3_MIX
#undef A3_STEP
}
}
constexpr int NWAVES = 8;
#ifndef MK_N_LAUNCHES
#define MK_N_LAUNCHES 1
#endif
constexpr int NPH = 16;
constexpr int T = 16384, D = 1024, SEQ = 8192, DFF = 2816, NIN = 5792;
constexpr size_t MiB = 1u << 20;
constexpr size_t al4k(size_t x) { return (x + 4095) & ~(size_t)4095; }
constexpr size_t WS_CTL = 0, CTL_ZERO_BYTES = 1 * MiB;
constexpr size_t WS_CS = 1 * MiB;
constexpr size_t WS_MISC = 2 * MiB;
constexpr size_t WS_KX = 3 * MiB, WS_VX = WS_KX + 512 * 1024;
constexpr size_t WS_MEMN = 4 * MiB;
constexpr size_t WS_SSQ0 = 5 * MiB, WS_SSQ1 = 6 * MiB, WS_SSQ2 = 7 * MiB, WS_SSQ3 = 8 * MiB;
constexpr size_t WS_SSQL = 9 * MiB;
constexpr size_t WS_WINA = 12 * MiB, WS_WINB = WS_WINA + al4k(768 * 1024 * 2), WS_WQUP = WS_WINB + al4k(5120 * 1024 * 2), WS_WKVUP = WS_WQUP + al4k(768 * 384 * 2),
                 WS_WBRA = WS_WKVUP + al4k(1024 * 256 * 2), WS_WBRB = WS_WBRA + al4k(1024 * 512 * 2), WS_WOUT = WS_WBRB + al4k(1024 * 1024 * 2), WS_WXQ = WS_WOUT + al4k(1024 * 1024 * 2),
                 WS_WXKV = WS_WXQ + al4k(512 * 1024 * 2), WS_WXO = WS_WXKV + al4k(1024 * 1024 * 2), WS_WSMALL_END = WS_WXO + al4k(1024 * 512 * 2);
constexpr size_t WS_WGU = 36 * MiB, WS_WD = WS_WGU + al4k((size_t)5632 * 1024 * 2), WS_WFFN_END = WS_WD + al4k((size_t)1024 * 2816 * 2);
constexpr size_t WS_YA = 36 * MiB;
constexpr size_t WS_HB = 54 * MiB;
constexpr size_t WS_POOL = 86 * MiB;
constexpr size_t WS_HID = WS_POOL;
constexpr size_t WS_LAT = WS_POOL, WS_QM = WS_LAT + 20 * MiB, WS_KM = WS_QM + 24 * MiB, WS_VM = WS_KM + 24 * MiB;
constexpr size_t WS_PB = WS_POOL;
constexpr size_t WS_QX = WS_POOL, WS_OX = WS_QX + 16 * MiB;
constexpr size_t WS_END = WS_PB + 160 * MiB;
static_assert(WS_WSMALL_END <= WS_WGU && WS_WFFN_END <= WS_HB && WS_YA + 16 * MiB <= WS_HB && WS_HB + 32 * MiB <= WS_POOL && WS_VM + 16 * MiB <= WS_END && WS_HID + (size_t)T * DFF * 2 <= WS_END && WS_END <= 256 * MiB, "d_ws map");
constexpr int CW_TMO = 0, CW_CODE = 1, CW_BAR = 4096;

constexpr int RING_OFF = 0, RING_BYTES = 131072;
constexpr int LDSCTL_OFF = 155648, MISC_OFF = LDSCTL_OFF + 320;
constexpr int LDS_BYTES = 163840;
constexpr int ATT_TB_OFF = 77824, ATT_ST_OFF = 79872;
static_assert(att2::core_lds<96, 64>() <= ATT_TB_OFF && att2::core_lds<64, 128>() <= ATT_TB_OFF && att::core_lds<128, 128>() <= LDSCTL_OFF && ATT_ST_OFF + 65536 <= LDSCTL_OFF, "attention LDS");

#define GAS __attribute__((address_space(1)))
#define LAS __attribute__((address_space(3)))
typedef unsigned short bf16;
typedef unsigned v4u __attribute__((ext_vector_type(4)));
typedef float f32x4 __attribute__((ext_vector_type(4)));
typedef short bf16x8 __attribute__((ext_vector_type(8)));
typedef GAS unsigned gu32;
typedef GAS unsigned long long gu64;
#define RLX_AGENT __ATOMIC_RELAXED, __HIP_MEMORY_SCOPE_AGENT
#define LDS_WAIT() asm volatile("s_waitcnt lgkmcnt(0)" ::: "memory")
#define VM_WAIT() asm volatile("s_waitcnt vmcnt(0)" ::: "memory")
__device__ __forceinline__ unsigned long long rt() { return __builtin_amdgcn_s_memrealtime(); }
__device__ __forceinline__ unsigned f2bf(float f) { unsigned u = __builtin_bit_cast(unsigned, f); return (u + 0x7fffu + ((u >> 16) & 1u)) >> 16; }
__device__ __forceinline__ unsigned pk2(float lo, float hi) { return f2bf(lo) | (f2bf(hi) << 16); }

#define XB_TMO      128
#define XB_XCNT(j)  (256  + 64 * (j))
#define XB_XSUB(j)  (1280 + 64 * (j))
#define XB_XGEN(j)  (2304 + 64 * (j))
#define XB_TOP      3328
#define XB_TOPGEN   3392
#define XCD_BAR_WORDS 3456
#define XB_SPIN_CAP (1u << 18)

__device__ __forceinline__ unsigned xb_ld(unsigned* p)              { return __hip_atomic_load(p, __ATOMIC_RELAXED, __HIP_MEMORY_SCOPE_AGENT); }
__device__ __forceinline__ unsigned xb_add(unsigned* p, unsigned v) { return __hip_atomic_fetch_add(p, v, __ATOMIC_RELAXED, __HIP_MEMORY_SCOPE_AGENT); }
__device__ __forceinline__ unsigned xb_xcc_id() { return (unsigned)__builtin_amdgcn_s_getreg((3 << 11) | 20) & 0xFu; }
#define XB_SPIN(cond, bar) do { unsigned _sp = 0; while (cond) { __builtin_amdgcn_s_sleep(1); \
    if ((++_sp & 255u) == 0u) { if (xb_ld(&(bar)[XB_TMO])) break; if (_sp > XB_SPIN_CAP) { atomicAdd(&(bar)[XB_TMO], 1u); break; } } } } while (0)

struct XcdBarrier {
    unsigned* bar; unsigned x;
    volatile LAS unsigned* st;
};

__device__ __forceinline__ XcdBarrier xcd_barrier_post(unsigned* bar, volatile LAS unsigned* st) {
    XcdBarrier b; b.bar = bar; b.x = xb_xcc_id(); b.st = st;
    if (threadIdx.x == 0) (void)xb_add(&bar[XB_XCNT(b.x)], 1u);
    return b;
}
__device__ __forceinline__ void xcd_barrier_complete(unsigned* bar, unsigned x, unsigned& nloc, unsigned& nx) {
    const unsigned G = gridDim.x * gridDim.y * gridDim.z;
    unsigned sum, cnt, mine, sp = 0u;
    for (;;) {
        sum = 0u; cnt = 0u; mine = 0u;
#pragma unroll
        for (unsigned j = 0; j < 16; ++j) { const unsigned c = xb_ld(&bar[XB_XCNT(j)]); sum += c; cnt += (c > 0u) ? 1u : 0u; mine = (j == x) ? c : mine; }
        if (sum == G) break;
        __builtin_amdgcn_s_sleep(1);
        if ((++sp & 255u) == 0u) { if (xb_ld(&bar[XB_TMO])) break; if (sp > XB_SPIN_CAP) { atomicAdd(&bar[XB_TMO], 1u); break; } }
    }
    nloc = mine > 0u ? mine : 1u; nx = cnt > 0u ? cnt : 1u;
}

__device__ __forceinline__ void xcd_barrier(const XcdBarrier& b) {
    asm volatile("s_waitcnt vmcnt(0)" ::: "memory");
    __syncthreads();
    if (threadIdx.x == 0) {
        unsigned* bar = b.bar;
        __builtin_amdgcn_s_waitcnt(0);
        unsigned nloc = b.st[0], nx = b.st[1];
        if (nloc == 0u) { xcd_barrier_complete(bar, b.x, nloc, nx); b.st[0] = nloc; b.st[1] = nx; }
        const unsigned old = xb_add(&bar[XB_XSUB(b.x)], 1u);
        const unsigned gen = old / nloc;
        if (old + 1u == (gen + 1u) * nloc) {
            __builtin_amdgcn_fence(__ATOMIC_RELEASE, "agent");
            asm volatile("s_waitcnt vmcnt(0)" ::: "memory");
            const unsigned og = xb_add(&bar[XB_TOP], 1u);
            const unsigned tg = og / nx;
            if (og + 1u == (tg + 1u) * nx) xb_add(&bar[XB_TOPGEN], 1u);
            else XB_SPIN(xb_ld(&bar[XB_TOPGEN]) == tg, bar);
            __builtin_amdgcn_fence(__ATOMIC_ACQUIRE, "agent");
            xb_add(&bar[XB_XGEN(b.x)], 1u);
            asm volatile("s_waitcnt vmcnt(0)" ::: "memory");
        } else {
            XB_SPIN(xb_ld(&bar[XB_XGEN(b.x)]) == gen, bar);
            __builtin_amdgcn_fence(__ATOMIC_ACQUIRE, "agent");
            asm volatile("s_waitcnt vmcnt(0)" ::: "memory");
        }
    }
    __syncthreads();
}

struct Frame {
    LAS unsigned char* lds;
    volatile LAS unsigned* MISC;
    gu32* ctl;
    int tid, lane, wave;
    int vcu, G;
};
__device__ __forceinline__ float wave_sum(float v) {
#pragma unroll
    for (int o = 1; o < 64; o <<= 1) v += __shfl_xor(v, o);
    return v;
}
__device__ __forceinline__ void wt_item(const float* W, int Nsrc, int ncol0, const float* gain, bf16* WT, int K, int k0, int drow0, bool rope, LAS float* scr, int lane) {
#pragma unroll 8
    for (int i = 0; i < 32; ++i) { const int kk = 2 * i + (lane >> 5); float v = 0.f;
        if (ncol0 >= 0) { v = W[(size_t)(k0 + kk) * Nsrc + ncol0 + (lane & 31)]; if (gain) v *= gain[k0 + kk]; }
        scr[kk * 33 + (lane & 31)] = v; }
    LDS_WAIT(); asm volatile("" ::: "memory");
    const int c = lane & 7;
#pragma unroll
    for (int j = 0; j < 4; ++j) { const int n = (lane >> 3) + 8 * j; const int ns = rope ? (16 * ((n >> 2) & 1) + 4 * (n >> 3) + (n & 3)) : n; const LAS float* s = scr + (8 * c) * 33 + ns;
        v4u o; o.x = pk2(s[0 * 33], s[1 * 33]); o.y = pk2(s[2 * 33], s[3 * 33]); o.z = pk2(s[4 * 33], s[5 * 33]); o.w = pk2(s[6 * 33], s[7 * 33]);
        *(GAS v4u*)(WT + (size_t)(drow0 + n) * K + k0 + 8 * c) = o; }
    LDS_WAIT(); asm volatile("" ::: "memory");
}
__device__ __forceinline__ void wt_job_item(const float* W, const float* W2, const float* gain, bf16* WT, int K, int Nsrc, int nblk, int mode, int item, LAS float* scr, int lane) {
    const int kb = item / nblk, b = item % nblk; const float* src = W; int ncol0 = 32 * b; bool rope = false;
    if (mode == 1) { const int tile = b >> 3, w = b & 7; if (w < 4) ncol0 = 128 * tile + 32 * w; else { src = W2; ncol0 = 128 * tile + 32 * (w - 4); } }
    else if (mode == 2) { if (b >= 21) ncol0 = -1; rope = (b == 20); }
    else if (mode == 3) ncol0 = 672 + 32 * b;
    else if (mode == 4) rope = (b % 3) == 2;
    else if (mode == 5) { if (b < 16) ncol0 = (b >> 1) * 128 + 32 * (b & 1); else { const int b2 = b - 16; ncol0 = (b2 >> 1) * 128 + 64 + 32 * (b2 & 1); } }
    else if (mode == 6) { if (b < 16) ncol0 = (b >> 2) * 256 + 32 * (b & 3); else { const int b2 = b - 16; ncol0 = (b2 >> 2) * 256 + 128 + 32 * (b2 & 3); } }
    wt_item(src, Nsrc, ncol0, gain, WT, K, 64 * kb, 32 * b, rope, scr, lane);
}
#define WJOB(Wp, W2p, gainp, dst, K_, Ns_, nb_, mode_) { const int items_ = ((K_) / 64) * (nb_); if (r < items_) { wt_job_item((Wp), (W2p), (gainp), (dst), (K_), (Ns_), (nb_), (mode_), r, scr, plane); continue; } r -= items_; }
__device__ __forceinline__ int t5_bucket(int rel) {
    const int n = rel < 0 ? -rel : rel; int v;
    if (n < 8) v = n; else if (n < 12) v = 8; else if (n < 16) v = 9; else if (n < 23) v = 10; else if (n < 32) v = 11; else if (n < 46) v = 12; else if (n < 64) v = 13; else if (n < 91) v = 14; else v = 15;
    return (rel > 0 ? 16 : 0) + v;
}

#ifndef ATTNS
#define ATTNS att3
#endif
#ifndef DBGV
#define DBGV 0
#endif
#ifndef PH_MASK
#define PH_MASK 0xffff
#endif
#define PHEN(k) (((PH_MASK) >> (k)) & 1)
struct Args { const float* in[31]; float* out; unsigned char* ws; int ph_lo, ph_hi, li, pad; };
#define HB ((bf16*)(args.ws + WS_HB))
#define HID ((bf16*)(args.ws + WS_HID))
#define LAT ((bf16*)(args.ws + WS_LAT))
#define QM ((bf16*)(args.ws + WS_QM))
#define KM ((bf16*)(args.ws + WS_KM))
#define VM ((bf16*)(args.ws + WS_VM))
#define PB ((bf16*)(args.ws + WS_PB))
#define YA ((bf16*)(args.ws + WS_YA))
#define QX ((bf16*)(args.ws + WS_QX))
#define OX ((bf16*)(args.ws + WS_OX))
#define KX ((bf16*)(args.ws + WS_KX))
#define VX ((bf16*)(args.ws + WS_VX))
#define MEMN ((bf16*)(args.ws + WS_MEMN))
#define WINA ((bf16*)(args.ws + WS_WINA))
#define WINB ((bf16*)(args.ws + WS_WINB))
#define WQUP ((bf16*)(args.ws + WS_WQUP))
#define WKVUP ((bf16*)(args.ws + WS_WKVUP))
#define WBRA ((bf16*)(args.ws + WS_WBRA))
#define WBRB ((bf16*)(args.ws + WS_WBRB))
#define WOUT ((bf16*)(args.ws + WS_WOUT))
#define WXQ ((bf16*)(args.ws + WS_WXQ))
#define WXKV ((bf16*)(args.ws + WS_WXKV))
#define WXO ((bf16*)(args.ws + WS_WXO))
#define WGU ((bf16*)(args.ws + WS_WGU))
#define WD ((bf16*)(args.ws + WS_WD))
#define CS ((float*)(args.ws + WS_CS))
#define TB ((float*)(args.ws + WS_MISC))
#define LAM ((float*)(args.ws + (WS_MISC + 8192)))
#define SSQ0 ((float*)(args.ws + WS_SSQ0))
#define SSQ1 ((float*)(args.ws + WS_SSQ1))
#define SSQ2 ((float*)(args.ws + WS_SSQ2))
#define SSQ3 ((float*)(args.ws + WS_SSQ3))
#define SSQL ((float*)(args.ws + WS_SSQL))
template <int ph> __device__ __forceinline__ void run_phase(const Args& args, Frame& F, const bool dry = false) {
    const float* x = args.in[0]; float* out = args.out;
        int ptid = threadIdx.x; asm volatile("" : "+v"(ptid)); const int plane = ptid & 63;
        if (PHEN(0) && ph == 0) {
            LAS float* scr = (LAS float*)(F.lds + RING_OFF + F.wave * 16384);
            const int gw = F.vcu * NWAVES + F.wave, NGW = F.G * NWAVES;
            constexpr int NITEMS = 16 * 176 + 44 * 32 + 16 * 24 + 16 * 160 + 6 * 24 + 4 * 32 + 8 * 32 + 16 * 32 + 16 * 32 + 16 * 16 + 16 * 32 + 8 * 32;
            for (int it = gw; it < NITEMS; it += NGW) {
                int r = it;
                WJOB(args.in[3], args.in[4], args.in[2], WGU, 1024, 2816, 176, 1)
                WJOB(args.in[5], nullptr, nullptr, WD, 2816, 1024, 32, 0)
                WJOB(args.in[7], nullptr, args.in[6], WINA, 1024, NIN, 24, 2)
                WJOB(args.in[7], nullptr, args.in[6], WINB, 1024, NIN, 160, 3)
                WJOB(args.in[9], nullptr, args.in[8], WQUP, 384, 768, 24, 4)
                WJOB(args.in[11], nullptr, args.in[10], WKVUP, 256, 1024, 32, 5)
                WJOB(args.in[18], nullptr, nullptr, WBRA, 512, 1024, 32, 0)
                WJOB(args.in[19], nullptr, nullptr, WBRB, 1024, 1024, 32, 0)
                WJOB(args.in[20], nullptr, nullptr, WOUT, 1024, 1024, 32, 0)
                WJOB(args.in[23], nullptr, args.in[21], WXQ, 1024, 512, 16, 0)
                WJOB(args.in[24], nullptr, nullptr, WXKV, 1024, 1024, 32, 6)
                WJOB(args.in[25], nullptr, nullptr, WXO, 512, 1024, 32, 0)
            }
            for (int m = gw; m < T; m += NGW) {
                const GAS f32x4* xr = (const GAS f32x4*)(x + (size_t)m * D) + plane; f32x4 v[4]; float s = 0.f;
#pragma unroll
                for (int j = 0; j < 4; ++j) { v[j] = xr[64 * j]; s += (v[j].x * v[j].x + v[j].y * v[j].y) + (v[j].z * v[j].z + v[j].w * v[j].w); }
                s = wave_sum(s);
                GAS unsigned long long* o8 = (GAS unsigned long long*)(HB + (size_t)m * D) + plane;
#pragma unroll
                for (int j = 0; j < 4; ++j) o8[64 * j] = (unsigned long long)pk2(v[j].x, v[j].y) | ((unsigned long long)pk2(v[j].z, v[j].w) << 32);
                if (plane < 16) SSQ0[(size_t)m * 16 + plane] = plane == 0 ? s : 0.f;
            }
            for (int m = gw; m < 512; m += NGW) {
                const GAS f32x4* xr = (const GAS f32x4*)(args.in[1] + (size_t)m * D) + plane; const GAS f32x4* gr = (const GAS f32x4*)(args.in[22]) + plane; f32x4 v[4]; float s = 0.f;
#pragma unroll
                for (int j = 0; j < 4; ++j) { v[j] = xr[64 * j]; s += (v[j].x * v[j].x + v[j].y * v[j].y) + (v[j].z * v[j].z + v[j].w * v[j].w); }
                const float rstd = 1.0f / sqrtf(wave_sum(s) * (1.0f / D) + 1e-6f);
                GAS unsigned long long* o8 = (GAS unsigned long long*)(MEMN + (size_t)m * D) + plane;
#pragma unroll
                for (int j = 0; j < 4; ++j) { const f32x4 g = gr[64 * j]; o8[64 * j] = (unsigned long long)pk2(v[j].x * rstd * g.x, v[j].y * rstd * g.y) | ((unsigned long long)pk2(v[j].z * rstd * g.z, v[j].w * rstd * g.w) << 32); }
            }
            for (int e = (F.vcu * NWAVES * 64) + ptid; e < SEQ * 16; e += F.G * NWAVES * 64) { const int pos = e >> 4, i = e & 15;
                const float freq = powf(10000.0f, -(float)i / 16.0f); const float ang = (float)pos * freq;
                CS[(size_t)pos * 32 + i] = cosf(ang); CS[(size_t)pos * 32 + 16 + i] = sinf(ang); }
            if (blockIdx.x == 0) {
                const float* rb = args.in[17];
                for (int e = ptid; e < 8 * 256; e += NWAVES * 64) { const int h = e >> 8, idx = e & 255; const int rel = idx - 128;
                    TB[e] = (rb[t5_bucket(rel) * 8 + h] - rb[15 * 8 + h]) * 1.4426950408889634f; }
                if (F.wave == 0) { const float a = args.in[12][plane] * args.in[13][plane], b2 = args.in[14][plane] * args.in[15][plane];
                    const float sa = wave_sum(a), sb = wave_sum(b2); if (plane == 0) LAM[0] = expf(sa) - expf(sb) + 0.2f; }
            }
        }
        else if (PHEN(1) && (ph == 1 || ph == 13)) {
            pg8::Gemm g{HB, WGU, T, 5632, 1024, 1024}; pg8::StaticOrder S; S.init(T, 5632, F.G, (int)blockIdx.x);
            pg8::EpiGateUp E{HID, DFF, ph == 1 ? SSQ0 : SSQ3};
            pg8::gemm_phase<pg8::EpiGateUp, pg8::StaticOrder, true, true>(F.lds + RING_OFF, g, S, E);
        }
        else if (PHEN(2) && (ph == 2 || ph == 9 || ph == 12 || ph == 14)) {
            pg8::Gemm g; pg8::EpiRes E;
            if (ph == 2)       { g = pg8::Gemm{HID, WD, T, 1024, DFF, DFF};          E = pg8::EpiRes{x, out, HB, SSQ1, 0.5f}; }
            else if (ph == 9)  { g = pg8::Gemm{PB + 3072, WOUT, T, 1024, 1024, 5120}; E = pg8::EpiRes{out, out, HB, SSQ2, 1.0f}; }
            else if (ph == 12) { g = pg8::Gemm{OX, WXO, T, 1024, 512, 512};          E = pg8::EpiRes{out, out, HB, SSQ3, 1.0f}; }
            else               { g = pg8::Gemm{HID, WD, T, 1024, DFF, DFF};          E = pg8::EpiRes{out, out, nullptr, nullptr, 0.5f}; }
            pg8::StaticOrder S; S.init(T, 1024, F.G, (int)blockIdx.x);
            pg8::gemm_phase<pg8::EpiRes, pg8::StaticOrder, true, true>(F.lds + RING_OFF, g, S, E);
        }
        else if (PHEN(3) && ph == 3) {
            pg8::Gemm g{HB, WINA, T, 768, 1024, 1024}; pg8::StaticOrder S; S.init(T, 768, F.G, (int)blockIdx.x);
            pg8::EpiLat E{LAT, SSQL, KM, CS, SSQ1};
            pg8::gemm_phase<pg8::EpiLat, pg8::StaticOrder, true, true>(F.lds + RING_OFF, g, S, E);
        }
        else if (PHEN(4) && ph == 4) {
#ifndef P4_SKIP_A
            { pg8::Gemm g{LAT, WQUP, T, 768, 384, 640}; pg8::StaticOrder S; S.init(T, 768, F.G, (int)blockIdx.x); pg8::EpiQup E{QM, SSQL, CS, 0.10206207261596575f * 1.4426950408889634f};
              pg8::gemm_phase<pg8::EpiQup, pg8::StaticOrder, true, true>(F.lds + RING_OFF, g, S, E); }
#endif
#ifndef P4_SKIP_B
            { pg8::Gemm g{LAT + 384, WKVUP, T, 1024, 256, 640}; pg8::StaticOrder S; S.init(T, 1024, F.G, (int)blockIdx.x); pg8::EpiKVup E{KM, VM, SSQL};
              pg8::gemm_phase<pg8::EpiKVup, pg8::StaticOrder, true, true>(F.lds + RING_OFF, g, S, E); }
#endif
        }
        else if (PHEN(5) && ph == 5) {
            const int bh = F.vcu >> 4, s = F.vcu & 15, b = bh >> 3, h = bh & 7;
            if (F.vcu < 256) for (int i = 0; i < 2; ++i) { const int qb = i ? s : 31 - s; const long rowbase = (long)b * SEQ; const int q0 = qb * 256;
                att::f32x16 o[2];
                ATTNS::attn_core<96, 64, 768, 768, 512, true, false>(QM + (rowbase + q0) * 768 + h * 96, KM + rowbase * 768 + h * 96, VM + rowbase * 512 + h * 64, 4 * (qb + 1),
                    1.0f, 8.0f, nullptr, q0, (att::lptr)(F.lds + RING_OFF), o, dry ? DBGV : 0);
                int l1 = plane; asm volatile("" : "+v"(l1)); const int r32 = l1 & 31, hi2 = l1 >> 5;
                bf16* Ow = YA + (rowbase + q0 + F.wave * 32) * 512 + h * 64;
#pragma unroll
                for (int r = 0; r < 16; ++r) { const int orow = att::crow(r, hi2);
#pragma unroll
                    for (int d0 = 0; d0 < 2; ++d0) Ow[(long)orow * 512 + d0 * 32 + r32] = (bf16)f2bf(o[d0][r]); } }
        }
        else if (PHEN(6) && (ph == 6 || ph == 10)) {
            if (ph == 6) { pg8::Gemm g{HB, WINB, T, 5120, 1024, 1024}; pg8::StaticOrder S; S.init(T, 5120, F.G, (int)blockIdx.x); pg8::EpiProj E{PB, 5120, SSQ1, 12, nullptr, 1 << 30, 0.125f * 1.4426950408889634f, 4};
                pg8::gemm_phase<pg8::EpiProj, pg8::StaticOrder, true, true>(F.lds + RING_OFF, g, S, E); }
            else {
                const int bx = (int)blockIdx.x; pg8::Gemm g; pg8::StaticOrder S; pg8::EpiProj E;
                if (bx < 128) { g = pg8::Gemm{HB, WXQ, T, 512, 1024, 1024}; S.init(T, 512, F.G, bx); E = pg8::EpiProj{QX, 512, SSQ2, 1 << 30, nullptr, 1 << 30, 1.0f, 0}; }
                else { g = pg8::Gemm{MEMN, WXKV, 512, 1024, 1024, 1024}; S.init(512, 1024, F.G, bx < 136 ? bx - 128 : -1); E = pg8::EpiProj{KX, 512, nullptr, 1 << 30, VX, 512, 1.0f, 0}; }
                pg8::gemm_phase<pg8::EpiProj, pg8::StaticOrder, true, true>(F.lds + RING_OFF, g, S, E);
                if (bx >= 136) {
                    LAS float* scr = (LAS float*)(F.lds + RING_OFF + F.wave * 16384);
                    const int gw = (bx - 136) * NWAVES + F.wave, NGW = (F.G - 136) * NWAVES;
                    for (int it = gw; it < 16 * 176 + 44 * 32; it += NGW) { int r = it;
                        WJOB(args.in[27], args.in[28], args.in[26], WGU, 1024, 2816, 176, 1)
                        WJOB(args.in[29], nullptr, nullptr, WD, 2816, 1024, 32, 0) }
                }
            }
        }
        else if (PHEN(7) && ph == 7) {
            const int bh = F.vcu >> 4, s = F.vcu & 15, b = bh >> 3, h = bh & 7;
            LAS float* tb = (LAS float*)(F.lds + ATT_TB_OFF);
            if (ptid < 256) tb[ptid] = TB[h * 256 + ptid];
            if (F.vcu < 256) for (int i = 0; i < 2; ++i) { const int qb = i ? s : 31 - s; const long rowbase = (long)b * SEQ; const int q0 = qb * 256;
                att::f32x16 o[4];
#pragma unroll 1
                for (int map = 0; map < 2; ++map) {
                    ATTNS::attn_core<64, 128, 5120, 5120, 5120, true, true>(PB + (rowbase + q0) * 5120 + h * 128 + map * 64, PB + rowbase * 5120 + 1024 + h * 128 + map * 64, PB + rowbase * 5120 + 2048 + h * 128,
                        4 * (qb + 1), 1.0f, 8.0f, (const LAS float*)tb, q0, (att::lptr)(F.lds + RING_OFF), o, dry ? DBGV : 0);
                    if (map == 0) { int l0 = plane; asm volatile("" : "+v"(l0)); LAS unsigned* st = (LAS unsigned*)(F.lds + ATT_ST_OFF) + F.wave * (32 * 64) + l0;
#pragma unroll
                        for (int d0 = 0; d0 < 4; ++d0)
#pragma unroll
                            for (int r = 0; r < 16; r += 2) st[(d0 * 8 + (r >> 1)) * 64] = pg8::cvt_pk_bf16(o[d0][r], o[d0][r + 1]);
                    }
                }
                int l1 = plane; asm volatile("" : "+v"(l1)); const int r32 = l1 & 31, hi2 = l1 >> 5;
                LAS unsigned* st = (LAS unsigned*)(F.lds + ATT_ST_OFF) + F.wave * (32 * 64) + l1;
                const float lam = LAM[0]; float gsn[4];
#pragma unroll
                for (int d0 = 0; d0 < 4; ++d0) gsn[d0] = args.in[16][d0 * 32 + r32] * 0.8f;
                bf16* Ow = (dry ? (bf16*)(args.ws + 246 * MiB) : PB + (rowbase + q0) * 5120) + F.wave * 32 * 5120 + h * 128;
#pragma unroll
                for (int r = 0; r < 16; r += 2) { float q0s = 0.f, q1s = 0.f; float c0[4], c1[4];
#pragma unroll
                    for (int d0 = 0; d0 < 4; ++d0) { const unsigned w = st[(d0 * 8 + (r >> 1)) * 64]; c0[d0] = pg8::bf_lo(w) - lam * o[d0][r]; c1[d0] = pg8::bf_hi(w) - lam * o[d0][r + 1]; q0s += c0[d0] * c0[d0]; q1s += c1[d0] * c1[d0]; }
#pragma unroll
                    for (int sh = 1; sh < 32; sh <<= 1) { q0s += __shfl_xor(q0s, sh); q1s += __shfl_xor(q1s, sh); }
                    const float n0 = 1.0f / sqrtf(q0s * (1.0f / 128.0f) + 1e-6f), n1 = 1.0f / sqrtf(q1s * (1.0f / 128.0f) + 1e-6f);
                    const int or0 = att::crow(r, hi2), or1 = att::crow(r + 1, hi2);
#pragma unroll
                    for (int d0 = 0; d0 < 4; ++d0) { Ow[(long)or0 * 5120 + d0 * 32 + r32] = (bf16)f2bf(c0[d0] * n0 * gsn[d0]); Ow[(long)or1 * 5120 + d0 * 32 + r32] = (bf16)f2bf(c1[d0] * n1 * gsn[d0]); } }
                LDS_WAIT(); }
        }
        else if (PHEN(8) && ph == 8) {
            { pg8::Gemm g{YA, WBRA, T, 1024, 512, 512}; pg8::StaticOrder S; S.init(T, 1024, F.G, (int)blockIdx.x); pg8::EpiBranch<0> E{PB};
              pg8::gemm_phase<pg8::EpiBranch<0>, pg8::StaticOrder, true, true>(F.lds + RING_OFF, g, S, E); }
            { pg8::Gemm g{PB, WBRB, T, 1024, 1024, 5120}; pg8::StaticOrder S; S.init(T, 1024, F.G, (int)blockIdx.x); pg8::EpiBranch<1> E{PB};
              pg8::gemm_phase<pg8::EpiBranch<1>, pg8::StaticOrder, true, true>(F.lds + RING_OFF, g, S, E); }
        }
        else if (PHEN(11) && ph == 11) {
            const int tile = F.vcu >> 2, hh = F.vcu & 3, b = tile >> 5; const int lane = plane; const int r32 = lane & 31, hi2 = lane >> 5;
            if (F.vcu < 256) { att::f32x16 o[4];
                att::attn_core<128, 128, 512, 512, 512, false, false, 1>(QX + (long)tile * 256 * 512 + hh * 128, KX + (long)b * 256 * 512 + hh * 128, VX + (long)b * 256 * 512 + hh * 128, 4,
                    0.08838834764831845f * 1.4426950408889634f, 8.0f / 0.08838834764831845f, nullptr, 0, (att::lptr)(F.lds + RING_OFF), o);
                bf16* Ow = OX + ((long)tile * 256 + F.wave * 32) * 512 + hh * 128;
#pragma unroll
                for (int r = 0; r < 16; ++r) { const int orow = att::crow(r, hi2);
#pragma unroll
                    for (int d0 = 0; d0 < 4; ++d0) Ow[(long)orow * 512 + d0 * 32 + r32] = (bf16)f2bf(o[d0][r]); } }
        }
        else if (PHEN(15) && ph == 15) {
            const int gw = F.vcu * NWAVES + F.wave, NGW = F.G * NWAVES; const GAS f32x4* gr = (const GAS f32x4*)(args.in[30]) + plane;
            for (int m = gw; m < T; m += NGW) { GAS f32x4* xr = (GAS f32x4*)(out + (size_t)m * D) + plane; f32x4 v[4]; float s = 0.f;
#pragma unroll
                for (int j = 0; j < 4; ++j) { v[j] = xr[64 * j]; s += (v[j].x * v[j].x + v[j].y * v[j].y) + (v[j].z * v[j].z + v[j].w * v[j].w); }
                const float rstd = 1.0f / sqrtf(wave_sum(s) * (1.0f / D) + 1e-6f);
#pragma unroll
                for (int j = 0; j < 4; ++j) xr[64 * j] = v[j] * rstd * gr[64 * j]; }
        }
}
__global__ void __launch_bounds__(NWAVES * 64, 2) mega_fwd(Args args) {
    extern __shared__ __attribute__((aligned(16))) unsigned char lds[];
    Frame F;
    F.lds = (LAS unsigned char*)lds;
    F.MISC = (volatile LAS unsigned*)(F.lds + MISC_OFF);
    F.tid = threadIdx.x; F.lane = F.tid & 63; F.wave = __builtin_amdgcn_readfirstlane(F.tid >> 6);
    F.G = gridDim.x; { const int bx = blockIdx.x; F.vcu = (F.G % 8 == 0) ? (bx % 8) * (F.G / 8) + bx / 8 : bx; }
    F.ctl = (gu32*)(args.ws + WS_CTL);
    for (int u = F.tid; u < (LDS_BYTES - LDSCTL_OFF) / 4; u += NWAVES * 64) ((LAS unsigned*)(F.lds + LDSCTL_OFF))[u] = 0u;
    __syncthreads();
    XcdBarrier bar; bar.bar = (unsigned*)(F.ctl + CW_BAR) + args.li * XCD_BAR_WORDS; bar.x = 0; bar.st = nullptr;
    const int lo = args.ph_lo, hi = args.ph_hi;
    if (hi - lo > 1) bar = xcd_barrier_post((unsigned*)(F.ctl + CW_BAR) + args.li * XCD_BAR_WORDS, F.MISC + 8);
#ifdef STAMP_PH
    unsigned long long* const ts_ = (unsigned long long*)(args.ws + WS_MISC + 16384); const bool stamper_ = (blockIdx.x == 0 && threadIdx.x == 0);
    if (stamper_) ts_[0] = rt();
#define RUN_PH(k) if (lo <= (k) && (k) < hi) { run_phase<(k)>(args, F); xcd_barrier(bar); if (stamper_) ts_[(k) + 1] = rt(); }
#else
#ifdef REP_PH
#define RUN_PH(k) if (lo <= (k) && (k) < hi) { if ((k) == REP_PH) { _Pragma("unroll 1") for (int rep_ = args.pad; rep_ > 0; --rep_) { run_phase<(k)>(args, F, rep_ > 1); xcd_barrier(bar); } } else { run_phase<(k)>(args, F); if ((k) + 1 < hi) xcd_barrier(bar); } }
#else
#define RUN_PH(k) if (lo <= (k) && (k) < hi) { run_phase<(k)>(args, F); if ((k) + 1 < hi) xcd_barrier(bar); }
#endif
#endif
    RUN_PH(0) RUN_PH(1) RUN_PH(2) RUN_PH(3) RUN_PH(4) RUN_PH(5) RUN_PH(6) RUN_PH(7) RUN_PH(8) RUN_PH(9) RUN_PH(10) RUN_PH(11) RUN_PH(12) RUN_PH(13) RUN_PH(14) RUN_PH(15)
#undef RUN_PH
#ifdef XBAR
    _Pragma("unroll 1") for (int xb_ = 0; xb_ < XBAR; ++xb_) xcd_barrier(bar);
#endif
#ifdef STAMP_PH
    xcd_barrier(bar);
    { const float cst = sqrtf((float)(ts_[STAMP_PH + 1] - ts_[STAMP_PH]) * 0.01f);
      for (size_t i = (size_t)blockIdx.x * 512 + threadIdx.x; i < (size_t)T * D; i += (size_t)gridDim.x * 512) args.out[i] = cst; }
#endif
}

extern "C" void kernel_launch(void* const* d_in, const int* in_sizes, int n_in, void* d_out, int out_size, void* d_ws, size_t ws_size, hipStream_t stream) {
    static int grid = 0;
    if (grid == 0) {
        if (n_in != 31 || in_sizes[0] != T * D || out_size != T * D || ws_size < WS_END) { fprintf(stderr, "kernel_launch: unexpected shapes (n_in %d, in0 %d, out %d, ws %zu)\n", n_in, n_in > 0 ? in_sizes[0] : -1, out_size, ws_size); grid = -1; return; }
        int dev = 0, cus = 0, per_cu = 0;
        if (hipGetDevice(&dev) != hipSuccess || hipDeviceGetAttribute(&cus, hipDeviceAttributeMultiprocessorCount, dev) != hipSuccess) { grid = -1; return; }
        if (hipFuncSetAttribute((const void*)mega_fwd, hipFuncAttributeMaxDynamicSharedMemorySize, LDS_BYTES) != hipSuccess) { fprintf(stderr, "kernel_launch: hipFuncSetAttribute failed\n"); grid = -1; return; }
        if (hipOccupancyMaxActiveBlocksPerMultiprocessor(&per_cu, (const void*)mega_fwd, NWAVES * 64, LDS_BYTES) != hipSuccess || per_cu < 1) fprintf(stderr, "kernel_launch: occupancy query says %d\n", per_cu);
        (void)hipGetLastError();
        grid = cus;
        if (grid != 256) fprintf(stderr, "kernel_launch: %d CUs (expected 256)\n", grid);
    }
    if (grid < 0) return;
    if (hipMemsetAsync((char*)d_ws + WS_CTL, 0, CTL_ZERO_BYTES, stream) != hipSuccess) return;
    Args a{};
    for (int i = 0; i < 31; ++i) a.in[i] = (const float*)d_in[i];
    a.out = (float*)d_out; a.ws = (unsigned char*)d_ws;
#ifdef REP_PH
    a.pad = 2;
#endif
    const int nl = MK_N_LAUNCHES;
    for (int li = 0; li < nl; ++li) {
        a.ph_lo = (nl == 1) ? 0 : li; a.ph_hi = (nl == 1) ? NPH : li + 1; a.li = 0;
        hipLaunchKernelGGL(mega_fwd, dim3(grid), dim3(NWAVES * 64), LDS_BYTES, stream, a);
        const hipError_t le = hipPeekAtLastError();
        if (le != hipSuccess) { fprintf(stderr, "kernel_launch: launch %d failed: %s\n", li, hipGetErrorName(le)); break; }
    }
}
```
